# Optimizing an MI355X kernel written in HIP

```python
import math
import jax, jax.numpy as jnp
from jax import lax
import numpy as np

D_MODEL = 1024
BATCH = 8
SEQ = 4096
DEPTH = 4

CHUNK = 64
SSM_WIDTH = D_MODEL // 4
SSM_GROUP = 16
SSM_GROUPS = SSM_WIDTH // SSM_GROUP
SSM_STATE = 64
GMLP_WIDTH = D_MODEL // 4
GMLP_HEADS = 4
GMLP_HEAD_DIM = GMLP_WIDTH // GMLP_HEADS
GMLP_WINDOW = 128
DIFF_WIDTH = D_MODEL // 2
DIFF_HEADS = 4
DIFF_VDIM = DIFF_WIDTH // DIFF_HEADS
DIFF_QK_DIM = DIFF_VDIM // 2
MIX_WIDTH = SSM_WIDTH + GMLP_WIDTH + DIFF_WIDTH
IN_COLS = SSM_WIDTH + 2 * GMLP_WIDTH + 3 * DIFF_WIDTH
D_FF = ((8 * D_MODEL // 3 + 127) // 128) * 128
CONV_WIDTH = 3
ROPE_THETA = 10000.0
Q_BLOCK = 128
EPS = 1e-6

kernel_name = "hybrid_s5_sgu_diffattn_trunk"


def rms_norm(x, g):
    xf = x.astype(jnp.float32)
    y = xf * lax.rsqrt(jnp.mean(xf * xf, axis=-1, keepdims=True) + EPS)
    return (y * g.astype(jnp.float32)).astype(x.dtype)


def rope_tables(seq):
    half = DIFF_QK_DIM // 2
    inv = ROPE_THETA ** (-jnp.arange(half, dtype=jnp.float32) / half)
    ang = jnp.arange(seq, dtype=jnp.float32)[:, None] * inv[None, :]
    ang = jnp.concatenate([ang, ang], axis=-1)
    return jnp.cos(ang), jnp.sin(ang)


def apply_rope(x, cos, sin):
    x1, x2 = jnp.split(x, 2, axis=-1)
    rot = jnp.concatenate([-x2, x1], axis=-1)
    c = cos[None, :, None, None, :]
    s = sin[None, :, None, None, :]
    return (x.astype(jnp.float32) * c + rot.astype(jnp.float32) * s).astype(x.dtype)


def s5_mixer(u, a_re, a_im, log_dt, b_re, b_im, c_re, c_im, d_skip, w_glu, b_glu):
    bsz, seq, _ = u.shape
    uf = u.astype(jnp.float32).reshape(bsz, seq, SSM_GROUPS, SSM_GROUP)
    lam = lax.complex(a_re.astype(jnp.float32), a_im.astype(jnp.float32))
    dt = jnp.exp(log_dt.astype(jnp.float32))[:, None]
    a_bar = jnp.exp(lam * dt)
    b_mat = lax.complex(b_re.astype(jnp.float32), b_im.astype(jnp.float32))
    b_bar = ((a_bar - 1.0) / lam)[..., None] * b_mat
    bu = jnp.einsum("bsgh,gph->bsgp", uf.astype(jnp.complex64), b_bar)

    def combine(left, right):
        a_l, b_l = left
        a_r, b_r = right
        return a_l * a_r, a_r * b_l + b_r

    a_seq = jnp.broadcast_to(a_bar, (1, seq) + a_bar.shape)
    _, states = lax.associative_scan(combine, (a_seq, bu), axis=1)
    c_mat = lax.complex(c_re.astype(jnp.float32), c_im.astype(jnp.float32))
    y = jnp.real(jnp.einsum("bsgp,ghp->bsgh", states, c_mat))
    y = y + d_skip.astype(jnp.float32).reshape(SSM_GROUPS, SSM_GROUP) * uf
    y = jax.nn.gelu(y.reshape(bsz, seq, SSM_WIDTH))
    y = y * jax.nn.sigmoid(y @ w_glu.astype(jnp.float32) + b_glu.astype(jnp.float32))
    return y.astype(u.dtype)


def spatial_gating(u, v, v_gain, w_s, b_s):
    bsz, seq, _ = u.shape
    v = rms_norm(v, v_gain)
    nwin = seq // GMLP_WINDOW
    v = v.reshape(bsz, nwin, GMLP_WINDOW, GMLP_HEADS, GMLP_HEAD_DIM)
    pos_chunk = jnp.arange(GMLP_WINDOW) // CHUNK
    mask = pos_chunk[None, :] <= pos_chunk[:, None]
    w = jnp.where(mask[None], w_s, 0).astype(v.dtype)
    mixed = jnp.einsum("hij,bnjhc->bnihc", w, v)
    mixed = mixed + b_s.astype(v.dtype).T[None, None, :, :, None]
    return u * mixed.reshape(bsz, seq, GMLP_WIDTH)


def diff_attention(q, k, v, q_gain, k_gain, lam_q1, lam_k1, lam_q2, lam_k2, sub_gain, lambda_init):
    bsz, seq, _ = q.shape
    q = q.reshape(bsz, seq, DIFF_HEADS, 2, DIFF_QK_DIM)
    k = k.reshape(bsz, seq, DIFF_HEADS, 2, DIFF_QK_DIM)
    v = v.reshape(bsz, seq, DIFF_HEADS, DIFF_VDIM)
    q = rms_norm(q, q_gain)
    k = rms_norm(k, k_gain)
    cos, sin = rope_tables(seq)
    q = apply_rope(q, cos, sin)
    k = apply_rope(k, cos, sin)
    lam = (jnp.exp(jnp.sum(lam_q1.astype(jnp.float32) * lam_k1.astype(jnp.float32)))
           - jnp.exp(jnp.sum(lam_q2.astype(jnp.float32) * lam_k2.astype(jnp.float32)))
           + lambda_init)
    nblk = seq // Q_BLOCK
    q_blocks = jnp.moveaxis(q.reshape(bsz, nblk, Q_BLOCK, DIFF_HEADS, 2, DIFF_QK_DIM), 1, 0)
    key_chunk = jnp.arange(seq) // CHUNK
    scale = DIFF_QK_DIM ** -0.5

    def block(args):
        qb, blk = args
        q_chunk = (blk * Q_BLOCK + jnp.arange(Q_BLOCK)) // CHUNK
        mask = key_chunk[None, :] <= q_chunk[:, None]
        s = jnp.einsum("bqhcd,bkhcd->bhcqk", qb, k).astype(jnp.float32) * scale
        s = jnp.where(mask, s, -jnp.inf)
        p = jax.nn.softmax(s, axis=-1)
        w = (p[:, :, 0] - lam * p[:, :, 1]).astype(v.dtype)
        return jnp.einsum("bhqk,bkhe->bqhe", w, v)

    out = lax.map(block, (q_blocks, jnp.arange(nblk)))
    out = jnp.moveaxis(out, 0, 1).reshape(bsz, seq, DIFF_HEADS, DIFF_VDIM)
    out = rms_norm(out, sub_gain) * (1.0 - lambda_init)
    return out.reshape(bsz, seq, DIFF_WIDTH)


def conv_gated_mlp(x, w_up, conv_w, conv_b, w_down):
    seq = x.shape[1]
    h = x @ w_up
    hp = jnp.pad(h, ((0, 0), (CONV_WIDTH - 1, 0), (0, 0)))
    acc = conv_b
    for i in range(CONV_WIDTH):
        acc = acc + conv_w[i] * hp[:, i:i + seq]
    gate, val = jnp.split(acc, 2, axis=-1)
    return (jax.nn.gelu(gate) * val) @ w_down


def setup_inputs(seed: int = 0) -> dict:
    key = jax.random.key(seed)
    ks = iter(jax.random.split(key, 40))

    def nrm(shape, std):
        return jax.random.normal(next(ks), shape, jnp.float32) * std

    L, G, P, C = DEPTH, SSM_GROUPS, SSM_STATE, SSM_GROUP
    x = nrm((BATCH, SEQ, D_MODEL), 1.0)
    attn_norm_g = 1.0 + nrm((L, D_MODEL), 0.02)
    w_in = nrm((L, D_MODEL, IN_COLS), D_MODEL ** -0.5)
    ssm_a_re = -0.5 + nrm((L, G, P), 0.01)
    ssm_a_im = jnp.pi * jnp.arange(P, dtype=jnp.float32)[None, None, :] + nrm((L, G, P), 0.01)
    ssm_log_dt = jax.random.uniform(next(ks), (L, G), jnp.float32, math.log(1e-3), math.log(1e-1))
    ssm_b_re = nrm((L, G, P, C), (2 * C) ** -0.5)
    ssm_b_im = nrm((L, G, P, C), (2 * C) ** -0.5)
    ssm_c_re = nrm((L, G, C, P), P ** -0.5)
    ssm_c_im = nrm((L, G, C, P), P ** -0.5)
    ssm_d = nrm((L, SSM_WIDTH), 1.0)
    ssm_w_glu = nrm((L, SSM_WIDTH, SSM_WIDTH), SSM_WIDTH ** -0.5)
    ssm_b_glu = nrm((L, SSM_WIDTH), 0.02)
    gmlp_v_g = 1.0 + nrm((L, GMLP_WIDTH), 0.02)
    gmlp_w_s = nrm((L, GMLP_HEADS, GMLP_WINDOW, GMLP_WINDOW), GMLP_WINDOW ** -0.5)
    gmlp_b_s = 1.0 + nrm((L, GMLP_HEADS, GMLP_WINDOW), 0.02)
    q_norm_g = 1.0 + nrm((L, DIFF_QK_DIM), 0.02)
    k_norm_g = 1.0 + nrm((L, DIFF_QK_DIM), 0.02)
    lambda_q1 = nrm((L, DIFF_QK_DIM), 0.1)
    lambda_k1 = nrm((L, DIFF_QK_DIM), 0.1)
    lambda_q2 = nrm((L, DIFF_QK_DIM), 0.1)
    lambda_k2 = nrm((L, DIFF_QK_DIM), 0.1)
    subln_g = 1.0 + nrm((L, DIFF_VDIM), 0.02)
    w_out = nrm((L, MIX_WIDTH, D_MODEL), MIX_WIDTH ** -0.5)
    ffn_norm_g = 1.0 + nrm((L, D_MODEL), 0.02)
    w_up = nrm((L, D_MODEL, 2 * D_FF), D_MODEL ** -0.5)
    conv_w = nrm((L, CONV_WIDTH, 2 * D_FF), CONV_WIDTH ** -0.5)
    conv_b = nrm((L, 2 * D_FF), 0.02)
    w_down = nrm((L, D_FF, D_MODEL), D_FF ** -0.5)
    return {"x": x, "attn_norm_g": attn_norm_g, "w_in": w_in,
            "ssm_a_re": ssm_a_re, "ssm_a_im": ssm_a_im, "ssm_log_dt": ssm_log_dt,
            "ssm_b_re": ssm_b_re, "ssm_b_im": ssm_b_im, "ssm_c_re": ssm_c_re, "ssm_c_im": ssm_c_im,
            "ssm_d": ssm_d, "ssm_w_glu": ssm_w_glu, "ssm_b_glu": ssm_b_glu,
            "gmlp_v_g": gmlp_v_g, "gmlp_w_s": gmlp_w_s, "gmlp_b_s": gmlp_b_s,
            "q_norm_g": q_norm_g, "k_norm_g": k_norm_g,
            "lambda_q1": lambda_q1, "lambda_k1": lambda_k1, "lambda_q2": lambda_q2, "lambda_k2": lambda_k2,
            "subln_g": subln_g, "w_out": w_out, "ffn_norm_g": ffn_norm_g,
            "w_up": w_up, "conv_w": conv_w, "conv_b": conv_b, "w_down": w_down}


def reference(x, attn_norm_g, w_in, ssm_a_re, ssm_a_im, ssm_log_dt, ssm_b_re, ssm_b_im,
              ssm_c_re, ssm_c_im, ssm_d, ssm_w_glu, ssm_b_glu, gmlp_v_g, gmlp_w_s, gmlp_b_s,
              q_norm_g, k_norm_g, lambda_q1, lambda_k1, lambda_q2, lambda_k2, subln_g, w_out,
              ffn_norm_g, w_up, conv_w, conv_b, w_down):
    o1 = SSM_WIDTH
    o2 = o1 + GMLP_WIDTH
    o3 = o2 + GMLP_WIDTH
    o4 = o3 + DIFF_WIDTH
    o5 = o4 + DIFF_WIDTH
    h = x
    for layer in range(DEPTH):
        lambda_init = 0.8 - 0.6 * math.exp(-0.3 * layer)
        xn = rms_norm(h, attn_norm_g[layer])
        proj = xn @ w_in[layer]
        u_ssm, u_g, v_g, q, k, v = jnp.split(proj, [o1, o2, o3, o4, o5], axis=-1)
        y_ssm = s5_mixer(u_ssm, ssm_a_re[layer], ssm_a_im[layer], ssm_log_dt[layer],
                         ssm_b_re[layer], ssm_b_im[layer], ssm_c_re[layer], ssm_c_im[layer],
                         ssm_d[layer], ssm_w_glu[layer], ssm_b_glu[layer])
        y_sgu = spatial_gating(u_g, v_g, gmlp_v_g[layer], gmlp_w_s[layer], gmlp_b_s[layer])
        y_diff = diff_attention(q, k, v, q_norm_g[layer], k_norm_g[layer],
                                lambda_q1[layer], lambda_k1[layer], lambda_q2[layer], lambda_k2[layer],
                                subln_g[layer], lambda_init)
        mixed = jnp.concatenate([y_ssm, y_sgu, y_diff], axis=-1)
        h = h + mixed @ w_out[layer]
        xn = rms_norm(h, ffn_norm_g[layer])
        h = h + conv_gated_mlp(xn, w_up[layer], conv_w[layer], conv_b[layer], w_down[layer])
    return h
```

```cpp
#include <hip/hip_runtime.h>
#include <hip/hip_cooperative_groups.h>
#include <cstdio>
#include <cstdint>
namespace cg = cooperative_groups;
constexpr int MTOK = 32768, SEQL = 4096, DMOD = 1024, NLAY = 4, INCOLS = 2304, DFF = 2816, UPC = 5632;
constexpr size_t MiB = 1u << 20;
constexpr size_t WS_SSQ = 438 * MiB;
constexpr size_t WS_MISC = 1 * MiB;
constexpr size_t WS_BAR = 1 * MiB + 65536;
constexpr size_t WS_ROPE = 2 * MiB;
constexpr size_t WS_WSB = 3 * MiB;
constexpr size_t WS_KTAB = 4 * MiB;
constexpr size_t WS_A64 = 6 * MiB;
constexpr size_t WS_BPOW = 8 * MiB;
constexpr size_t WS_CPOW = 24 * MiB;
constexpr size_t WS_WGLU = 40 * MiB;
constexpr size_t WS_WIN = 41 * MiB;
constexpr size_t WS_WOUT = 60 * MiB;
constexpr size_t WS_WUP = 68 * MiB;
constexpr size_t WS_WDN = 112 * MiB;
constexpr size_t WS_HB = 136 * MiB;
constexpr size_t WS_RTOP = 200 * MiB;
constexpr size_t WS_RBOT = 206 * MiB;
constexpr size_t WS_US = 212 * MiB;
constexpr size_t WS_UG = 228 * MiB;
constexpr size_t WS_VG = 244 * MiB;
constexpr size_t WS_QB = 260 * MiB;
constexpr size_t WS_KB = 292 * MiB;
constexpr size_t WS_VT = 324 * MiB;
constexpr size_t WS_YS = 356 * MiB;
constexpr size_t WS_MIX = 372 * MiB;
constexpr size_t WS_G = 212 * MiB;
constexpr size_t WS_END = 442 * MiB;
constexpr int LDS_BYTES = 147456, XL_OFF = 131072, BARST_OFF = 139264;
namespace pg8 {
#define PG8_LAS __attribute__((address_space(3)))
typedef unsigned short bf16_t;
typedef short bf16x8 __attribute__((ext_vector_type(8)));
typedef float f32x4 __attribute__((ext_vector_type(4)));
typedef unsigned u32x4 __attribute__((ext_vector_type(4)));
constexpr int BM = 256, BK = 64, HALF = 128, HTB = HALF * BK * 2  , STAGE_BYTES = 8 * HTB, NXCD = 8, WGM = 8;

__host__ __device__ __forceinline__ int lds_byte(int r, int c) { const int st = (r >> 4) * 2 + (c >> 5), rr = r & 15, cc = c & 31, ob = rr * 64 + cc * 2; return st * 1024 + (ob ^ (((ob >> 9) & 1) << 5)); }
__host__ __device__ __forceinline__ void stage_rc(int b, int& R, int& C) { const int st = b / 1024, sb = b % 1024, swz = sb ^ (((sb >> 9) & 1) << 5); R = (st >> 1) * 16 + swz / 64; C = (st & 1) * 32 + (swz % 64) / 2; }
__host__ __device__ __forceinline__ int perm32(int rho) { const int n = rho >> 4, i = rho & 15; return 8 * (i >> 2) + 4 * n + (i & 3); }

struct Unit { int pm, pn; };
struct Gemm { const bf16_t* A; const bf16_t* Bt; int M, N, K; };

struct StaticOrder {
    int nM, nN, nwg, G, c;
    __host__ __device__ void init(int M, int N, int G_, int c_) { nM = M / BM; nN = N / BM; nwg = nM * nN; G = G_; c = c_; }
    __host__ __device__ bool next(int i, Unit& u) const {
        const long L = (long)i * G + c; if (L >= nwg) return false;
        int wgid = (int)L; { const int q = nwg / NXCD, r = nwg % NXCD, xcd = wgid % NXCD, off = wgid / NXCD; wgid = (xcd < r ? xcd * (q + 1) : r * (q + 1) + (xcd - r) * q) + off; }
        const int nig = WGM * nN, gid = wgid / nig, fm = gid * WGM, gsz = (nM - fm) < WGM ? (nM - fm) : WGM;
        u.pm = fm + ((wgid % nig) % gsz); u.pn = (wgid % nig) / gsz; return true;
    }
    __device__ __forceinline__ void a_ready(const Unit&) const {}
    __device__ __forceinline__ void done(const Unit&) const {}
};

struct FixedOrder {
    int pm, pn0, n;
    __host__ __device__ bool next(int i, Unit& u) const { if (i >= n) return false; u.pm = pm; u.pn = pn0 + i; return true; }
    __device__ __forceinline__ void a_ready(const Unit&) const {}
    __device__ __forceinline__ void done(const Unit&) const {}
};

struct InProjOrder {
    int base, i, j;
    __host__ __device__ void init(int bx) { const int idx = bx >> 3; base = (bx & 7) * 16; i = idx >> 2; j = idx & 3; }
    __host__ __device__ bool next(int k, Unit& u) const {
        if (k == 0) { u.pm = base + i; u.pn = 1 + 2 * j; return true; }
        if (k == 1) { u.pm = base + i; u.pn = (j == 0) ? 2 : (j == 1) ? 8 : (j == 2) ? 6 : 4; return true; }
        if (k == 2) { u.pm = base + 8 + i; u.pn = (j == 0) ? 3 : (j == 1) ? 1 : 1 + 2 * j; return true; }
        if (k == 3) { u.pm = base + 8 + i; u.pn = (j == 0) ? 8 : (j == 1) ? 2 : (j == 2) ? 6 : 4; return true; }
        if (k == 4 && j >= 2) { u.pm = base + (j == 3 ? 8 : 0) + i; u.pn = 0; return true; }
        return false;
    }
    __host__ __device__ int sgu_panel() const { return j == 0 ? base + i : (j == 1 ? base + 8 + i : -1); }
    __device__ __forceinline__ void a_ready(const Unit&) const {}
    __device__ __forceinline__ void done(const Unit&) const {}
};

__device__ __forceinline__ unsigned cvt_pk_bf16(float lo, float hi) { unsigned r; asm volatile("v_cvt_pk_bf16_f32 %0, %1, %2" : "=v"(r) : "v"(lo), "v"(hi)); return r; }
typedef float f32x2 __attribute__((ext_vector_type(2)));
__device__ __forceinline__ f32x2 gelu_pk(f32x2 v) {
    const f32x2 av = __builtin_elementwise_abs(v), d = av * 0.2316418882f + 1.0f;
    f32x2 t; t.x = __builtin_amdgcn_rcpf(d.x); t.y = __builtin_amdgcn_rcpf(d.y);
    f32x2 q = t * 0.5307027145f + (-0.7265760135f); q = q * t + 0.7107068705f; q = q * t + (-0.142248368f); q = q * t + 0.127414796f; q = q * t;
    const f32x2 s = (v * v) * (-0.72134752044f);
    f32x2 e; e.x = __builtin_amdgcn_exp2f(s.x); e.y = __builtin_amdgcn_exp2f(s.y);
    const f32x2 m = v * (q * e), r = v - m;
    f32x2 o; o.x = v.x < 0.f ? m.x : r.x; o.y = v.y < 0.f ? m.y : r.y; return o;
}

__device__ __forceinline__ int lane_id_op() { int t; asm volatile("v_mbcnt_lo_u32_b32 %0, -1, 0\n\tv_mbcnt_hi_u32_b32 %0, -1, %0" : "=v"(t)); return t; }
__device__ __forceinline__ float xsum16(float s) { return s + __int_as_float(__builtin_amdgcn_ds_swizzle(__float_as_int(s), 0x401F)); }
__device__ __forceinline__ float xsum32(float s) { auto rr = __builtin_amdgcn_permlane32_swap(__float_as_uint(s), __float_as_uint(s), false, false); return __uint_as_float(rr[0]) + __uint_as_float(rr[1]); }
__device__ __forceinline__ float xmax32(float s) { auto rr = __builtin_amdgcn_permlane32_swap(__float_as_uint(s), __float_as_uint(s), false, false); return fmaxf(__uint_as_float(rr[0]), __uint_as_float(rr[1])); }
#define DPPF(v, ctrl) __int_as_float(__builtin_amdgcn_mov_dpp(__float_as_int(v), (ctrl), 0xf, 0xf, true))
__device__ __forceinline__ float wave_sum64(float v) {
    v += DPPF(v, 0xB1); v += DPPF(v, 0x4E); v += DPPF(v, 0x141); v += DPPF(v, 0x140);
    v = xsum16(v); v = xsum32(v); return v;
}
typedef unsigned u32x2 __attribute__((ext_vector_type(2)));
#ifndef UPV
#define UPV 0
#endif
#define EFENCE() do { asm volatile("" ::: "memory"); __builtin_amdgcn_sched_barrier(0); } while (0)
__device__ __forceinline__ float gelu_tanh(float x) {
    const float u = x * (0.7978845608f + 0.0356774081f * x * x);
    const float e = __builtin_amdgcn_exp2f(-2.885390082f * u);
    return x * __builtin_amdgcn_rcpf(1.0f + e);
}
__device__ __forceinline__ float sigmoidf_(float z) { return __builtin_amdgcn_rcpf(1.0f + __builtin_amdgcn_exp2f(-1.4426950409f * z)); }
__device__ __forceinline__ float bflo(unsigned w) { return __uint_as_float(w << 16); }
__device__ __forceinline__ float bfhi(unsigned w) { return __uint_as_float(w & 0xffff0000u); }
__device__ __forceinline__ unsigned short f2bf1(float f) { return (unsigned short)(cvt_pk_bf16(f, 0.f) & 0xffffu); }

__device__ __forceinline__ float row_ssq4(const float* base, int row) {
    const f32x4 a = *(const f32x4*)((const char*)base + (unsigned)row * 16u);
    return (a[0] + a[1]) + (a[2] + a[3]);
}
__device__ __forceinline__ void row_scales8(float (&rs)[8], const float* ssq, int row0) {
    float t[8];
#pragma unroll
    for (int i = 0; i < 8; ++i) t[i] = row_ssq4(ssq, row0 + (i >> 2) * HALF + (i & 3) * 16);
#pragma unroll
    for (int i = 0; i < 8; ++i) rs[i] = rsqrtf(t[i] * (1.0f / 1024.0f) + 1e-6f);
}
struct EpiInProj {
    static constexpr bool PERM = true, AFTER_DRAIN = false, CONSTK = false;
    const float* ssq; bf16_t *US, *UG, *VG, *QB, *KB, *VT; const float *qg, *kg; const float* rope;
    __device__ __forceinline__ void operator()(const f32x4 (&acc)[2][2][4][2], const Unit& u, int wr, int wc, int fr, int fq) const {
        asm volatile("" : "+v"(fr), "+v"(fq));
        const int pn = u.pn;
        const bool isqk = (pn >= 3 && pn < 7), isk = pn >= 5;
        float rs8[8]; row_scales8(rs8, ssq, u.pm * BM + wr * 64 + fr);
#pragma unroll
        for (int ai = 0; ai < 2; ++ai) {
#pragma unroll
            for (int m = 0; m < 4; ++m) {
                const int row = u.pm * BM + ai * HALF + wr * 64 + m * 16 + fr;
                const float rs = rs8[ai * 4 + m];
                f32x4 x[2][2];
#pragma unroll
                for (int bj = 0; bj < 2; ++bj)
#pragma unroll
                    for (int n = 0; n < 2; ++n) x[bj][n] = acc[ai][bj][m][n] * rs;
                const int b = row >> 12, s = row & 4095;
                if (pn < 3) {
#pragma unroll
                    for (int bj = 0; bj < 2; ++bj) {
                        const int p = bj * 128 + wc * 32 + fq * 8;
                        u32x4 w; w.x = cvt_pk_bf16(x[bj][0][0], x[bj][0][1]); w.y = cvt_pk_bf16(x[bj][0][2], x[bj][0][3]); w.z = cvt_pk_bf16(x[bj][1][0], x[bj][1][1]); w.w = cvt_pk_bf16(x[bj][1][2], x[bj][1][3]);
                        bf16_t* dst = (pn == 0) ? US + ((size_t)(p >> 4) * MTOK + row) * 16 + (p & 15) : ((pn == 1) ? UG : VG) + (size_t)row * 256 + p;
                        *(u32x4*)dst = w;
                    }
                } else if (isqk) {
                    float ss = 0.f;
#pragma unroll
                    for (int bj = 0; bj < 2; ++bj)
#pragma unroll
                        for (int n = 0; n < 2; ++n) { const f32x4 v = x[bj][n]; ss += (v[0] * v[0] + v[1] * v[1]) + (v[2] * v[2] + v[3] * v[3]); }
                    ss = xsum16(ss); ss = xsum32(ss);
                    const float rinv = rsqrtf(ss * (1.0f / 64.0f) + 1e-6f) ;
                    const float osc = isk ? 1.0f : 0.18033688011112042f;
                    const float* Gq = isk ? kg : qg; f32x4 gn[2][2];
#pragma unroll
                    for (int bj = 0; bj < 2; ++bj)
#pragma unroll
                        for (int n = 0; n < 2; ++n) gn[bj][n] = *(const f32x4*)(Gq + 32 * bj + 8 * fq + 4 * n);
                    const f32x4* rp = (const f32x4*)(rope + ((size_t)s * 32 + 8 * fq) * 2);
                    const int hm = 4 * ((pn - 3) & 1) + wc, head = hm >> 1, c = hm & 1;
                    bf16_t* dst = (isk ? KB : QB) + ((((size_t)(b * 4 + head) * 2 + c) * 4096 + s) * 64) + 8 * fq;
                    float o1[8], o2[8];
#pragma unroll
                    for (int n = 0; n < 2; ++n) {
                        const f32x4 ra = rp[2 * n], rb = rp[2 * n + 1];
                        const float cs[4] = {ra[0], ra[2], rb[0], rb[2]}, sn[4] = {ra[1], ra[3], rb[1], rb[3]};
#pragma unroll
                        for (int e = 0; e < 4; ++e) {
                            const float y1 = x[0][n][e] * rinv * gn[0][n][e], y2 = x[1][n][e] * rinv * gn[1][n][e];
                            o1[4 * n + e] = (y1 * cs[e] - y2 * sn[e]) * osc; o2[4 * n + e] = (y2 * cs[e] + y1 * sn[e]) * osc;
                        }
                    }
                    u32x4 w1, w2;
                    w1.x = cvt_pk_bf16(o1[0], o1[1]); w1.y = cvt_pk_bf16(o1[2], o1[3]); w1.z = cvt_pk_bf16(o1[4], o1[5]); w1.w = cvt_pk_bf16(o1[6], o1[7]);
                    w2.x = cvt_pk_bf16(o2[0], o2[1]); w2.y = cvt_pk_bf16(o2[2], o2[3]); w2.z = cvt_pk_bf16(o2[4], o2[5]); w2.w = cvt_pk_bf16(o2[6], o2[7]);
                    *(u32x4*)dst = w1; *(u32x4*)(dst + 32) = w2;
                } else {
                    const int par = fr & 1, se = s & ~1;
                    const int spe = (se & ~12) | ((se & 4) << 1) | ((se & 8) >> 1);
#pragma unroll
                    for (int bj = 0; bj < 2; ++bj) {
                        const int head = (pn - 7) * 2 + bj;
                        bf16_t* dstb = VT + ((((size_t)(b * 4 + head) * 64 + (spe >> 6)) * 128 + wc * 32 + fq * 8 + par) * 64 + (spe & 63));
#pragma unroll
                        for (int k = 0; k < 4; ++k) {
                            const float a0 = x[bj][k >> 1][2 * (k & 1)], a1 = x[bj][k >> 1][2 * (k & 1) + 1];
                            const float t0 = DPPF(a0, 0xB1), t1 = DPPF(a1, 0xB1);
                            const float lo = par ? t1 : a0, hi = par ? a1 : t0;
                            *(unsigned*)(dstb + (size_t)(2 * k) * 64) = cvt_pk_bf16(lo, hi);
                        }
                    }
                }
                EFENCE();
            }
        }
    }
};

struct EpiResid {
    static constexpr bool PERM = true, AFTER_DRAIN = false, CONSTK = false;
    const float* basef; float* outf; bf16_t* hb; float* ssq_out; PG8_LAS float* xs;
    __device__ __forceinline__ void operator()(const f32x4 (&acc)[2][2][4][2], const Unit& u, int wr, int wc, int fr, int fq) const {
        asm volatile("" : "+v"(fr), "+v"(fq));
        const size_t off0 = (size_t)(u.pm * BM + wr * 64 + fr) * 1024 + u.pn * BM + wc * 32 + 8 * fq;
#pragma unroll
        for (int ai = 0; ai < 2; ++ai) {
            f32x4 bv[4][2][2];
            if (basef) {
#pragma unroll
                for (int m = 0; m < 4; ++m)
#pragma unroll
                    for (int bj = 0; bj < 2; ++bj)
#pragma unroll
                        for (int n = 0; n < 2; ++n) bv[m][bj][n] = *(const f32x4*)(basef + off0 + (size_t)(ai * HALF + m * 16) * 1024 + bj * HALF + n * 4);
            } else {
                u32x4 hv[4][2];
#pragma unroll
                for (int m = 0; m < 4; ++m)
#pragma unroll
                    for (int bj = 0; bj < 2; ++bj) hv[m][bj] = *(const u32x4*)(hb + off0 + (size_t)(ai * HALF + m * 16) * 1024 + bj * HALF);
#pragma unroll
                for (int m = 0; m < 4; ++m)
#pragma unroll
                    for (int bj = 0; bj < 2; ++bj) { const u32x4 h4 = hv[m][bj];
                        bv[m][bj][0] = (f32x4){bflo(h4.x), bfhi(h4.x), bflo(h4.y), bfhi(h4.y)}; bv[m][bj][1] = (f32x4){bflo(h4.z), bfhi(h4.z), bflo(h4.w), bfhi(h4.w)}; }
            }
#pragma unroll
            for (int m = 0; m < 4; ++m) {
                const int row = u.pm * BM + ai * HALF + wr * 64 + m * 16 + fr;
                const size_t off = off0 + (size_t)(ai * HALF + m * 16) * 1024;
                float ss = 0.f;
#pragma unroll
                for (int bj = 0; bj < 2; ++bj) {
                    const f32x4 o0 = bv[m][bj][0] + acc[ai][bj][m][0], o1 = bv[m][bj][1] + acc[ai][bj][m][1];
                    if (outf) { __builtin_nontemporal_store(o0, (f32x4*)(outf + off + bj * HALF)); __builtin_nontemporal_store(o1, (f32x4*)(outf + off + bj * HALF + 4)); }
                    ss += ((o0[0] * o0[0] + o0[1] * o0[1]) + (o0[2] * o0[2] + o0[3] * o0[3])) + ((o1[0] * o1[0] + o1[1] * o1[1]) + (o1[2] * o1[2] + o1[3] * o1[3]));
                    u32x4 w; w.x = cvt_pk_bf16(o0[0], o0[1]); w.y = cvt_pk_bf16(o0[2], o0[3]); w.z = cvt_pk_bf16(o1[0], o1[1]); w.w = cvt_pk_bf16(o1[2], o1[3]);
                    if (!outf) *(u32x4*)(hb + off + bj * HALF) = w;
                }
                if (ssq_out) { ss = xsum16(ss); ss = xsum32(ss); if (fq == 0) xs[(ai * HALF + wr * 64 + m * 16 + fr) * 4 + wc] = ss; }
            }
            EFENCE();
        }
        if (ssq_out) {
            asm volatile("s_waitcnt lgkmcnt(0)" ::: "memory"); __builtin_amdgcn_s_barrier(); asm volatile("" ::: "memory");
            if (wr == 0) { const int t = wc * 64 + fq * 16 + fr; const f32x4 v = *(const PG8_LAS f32x4*)(xs + t * 4);
                ssq_out[(size_t)(u.pm * BM + t) * 4 + u.pn] = (v[0] + v[1]) + (v[2] + v[3]); }
        }
    }
};

struct EpiGlu {
    static constexpr bool PERM = true, AFTER_DRAIN = false, CONSTK = false;
    const bf16_t* YS; const float* bias; bf16_t* MIX;
    __device__ __forceinline__ void operator()(const f32x4 (&acc)[2][2][4][2], const Unit& u, int wr, int wc, int fr, int fq) const {
        asm volatile("" : "+v"(fr), "+v"(fq));
#pragma unroll
        for (int bj = 0; bj < 2; ++bj)
#pragma unroll
            for (int n = 0; n < 2; ++n) {
                const int p = bj * 128 + wc * 32 + fq * 8 + 4 * n;
                const f32x4 b0 = *(const f32x4*)(bias + p);
#pragma unroll
                for (int ai = 0; ai < 2; ++ai)
#pragma unroll
                    for (int m = 0; m < 4; ++m) {
                        const int row = u.pm * BM + ai * HALF + wr * 64 + m * 16 + fr;
                        const u32x2 yv = *(const u32x2*)(YS + (size_t)row * 256 + p);
                        const f32x4 z = acc[ai][bj][m][n] + b0;
                        u32x2 w; w.x = cvt_pk_bf16(bflo(yv.x) * sigmoidf_(z[0]), bfhi(yv.x) * sigmoidf_(z[1])); w.y = cvt_pk_bf16(bflo(yv.y) * sigmoidf_(z[2]), bfhi(yv.y) * sigmoidf_(z[3]));
                        *(u32x2*)(MIX + (size_t)row * 1024 + p) = w;
                        if (m & 1) EFENCE();
                    }
            }
    }
};

struct EpiUp {
    static constexpr bool PERM = true, AFTER_DRAIN = false, CONSTK = true;
    unsigned char* ws; const float* cw; const float* cb; PG8_LAS f32x4* xl;
    __device__ __forceinline__ void operator()(f32x4 (&acc)[2][2][4][2], const Unit& u, int wr, int wc, int fr, int fq) const {
        asm volatile("" : "+v"(fr), "+v"(fq));
        const int wid = wr * 4 + wc;
        const int cgb = u.pn * 128 + wc * 32 + fq * 8;
        const float* ssq = (const float*)(ws + WS_SSQ) + (size_t)MTOK * 4; bf16_t* G = (bf16_t*)(ws + WS_G); float* rawTop = (float*)(ws + WS_RTOP); float* rawBot = (float*)(ws + WS_RBOT);
        float rs8[8]; row_scales8(rs8, ssq, u.pm * BM + wr * 64 + fr);
#pragma unroll
        for (int ai = 0; ai < 2; ++ai)
#pragma unroll
            for (int m = 0; m < 4; ++m) {
                const int row = u.pm * BM + ai * HALF + wr * 64 + m * 16 + fr;
                const float rs = rs8[ai * 4 + m];
#pragma unroll
                for (int bj = 0; bj < 2; ++bj)
#pragma unroll
                    for (int n = 0; n < 2; ++n) acc[ai][bj][m][n] = acc[ai][bj][m][n] * rs;
            }
#if UPV != 3
        if (fr >= 14) {
#pragma unroll
            for (int ai = 0; ai < 2; ++ai)
#pragma unroll
                for (int bj = 0; bj < 2; ++bj)
#pragma unroll
                    for (int n = 0; n < 2; ++n) xl[((((wid * 2 + ai) * 2 + (fr - 14)) * 2 + bj) * 4 + fq) * 2 + n] = acc[ai][bj][3][n];
        }
        if (wr == 0 && fr < 2) {
#pragma unroll
            for (int bj = 0; bj < 2; ++bj)
#pragma unroll
                for (int n = 0; n < 2; ++n) *(f32x4*)(rawTop + ((size_t)u.pm * 2 + fr) * UPC + bj * DFF + cgb + 4 * n) = acc[0][bj][0][n];
        }
        if (wr == 1 && fr >= 14) {
#pragma unroll
            for (int bj = 0; bj < 2; ++bj)
#pragma unroll
                for (int n = 0; n < 2; ++n) *(f32x4*)(rawBot + ((size_t)u.pm * 2 + (fr - 14)) * UPC + bj * DFF + cgb + 4 * n) = acc[1][bj][3][n];
        }
#endif
        asm volatile("s_waitcnt lgkmcnt(0)" ::: "memory"); __builtin_amdgcn_s_barrier(); asm volatile("" ::: "memory");
        const int src = wid ^ 4;
#pragma unroll
        for (int bj = 0; bj < 2; ++bj)
#pragma unroll
            for (int n = 0; n < 2; ++n) {
                const f32x4 wb = *(const f32x4*)(cb + bj * DFF + cgb + 4 * n), w0 = *(const f32x4*)(cw + bj * DFF + cgb + 4 * n), w1 = *(const f32x4*)(cw + UPC + bj * DFF + cgb + 4 * n), w2 = *(const f32x4*)(cw + 2 * UPC + bj * DFF + cgb + 4 * n);
#pragma unroll
                for (int ai = 0; ai < 2; ++ai)
#pragma unroll
                    for (int mm = 0; mm < 4; ++mm) {
                        const int m = 3 - mm;
                        f32x4 pb;
                        if (m > 0) pb = acc[ai][bj][m - 1][n];
                        else if (wr == 1) pb = xl[((((src * 2 + ai) * 2 + (fr & 1)) * 2 + bj) * 4 + fq) * 2 + n];
                        else if (ai == 1) pb = xl[((((src * 2 + 0) * 2 + (fr & 1)) * 2 + bj) * 4 + fq) * 2 + n];
                        else pb = (f32x4){0.f, 0.f, 0.f, 0.f};
                        const f32x4 cur = acc[ai][bj][m][n]; f32x4 cv;
#pragma unroll
                        for (int e = 0; e < 4; ++e) {
                            const int pbi = __float_as_int(pb[e]), ci = __float_as_int(cur[e]);
                            const int r1 = __builtin_amdgcn_mov_dpp(pbi, 0x121, 0xf, 0xf, false);
                            const int r2 = __builtin_amdgcn_mov_dpp(pbi, 0x122, 0xf, 0xf, false);
                            const float p1 = __int_as_float(__builtin_amdgcn_update_dpp(r1, ci, 0x111, 0xf, 0xf, false));
                            const float p2 = __int_as_float(__builtin_amdgcn_update_dpp(r2, ci, 0x112, 0xf, 0xf, false));
                            cv[e] = wb[e] + w2[e] * cur[e] + w1[e] * p1 + w0[e] * p2;
                        }
                        asm volatile("" : "+v"(cv));
                        acc[ai][bj][m][n] = cv;
                    }
            }
#pragma unroll
        for (int ai = 0; ai < 2; ++ai)
#pragma unroll
            for (int m = 0; m < 4; ++m) {
                const int row = u.pm * BM + ai * HALF + wr * 64 + m * 16 + fr;
                const f32x4 g0 = acc[ai][0][m][0], g1 = acc[ai][0][m][1], v0 = acc[ai][1][m][0], v1 = acc[ai][1][m][1];
                u32x4 w; w.x = cvt_pk_bf16(gelu_tanh(g0[0]) * v0[0], gelu_tanh(g0[1]) * v0[1]); w.y = cvt_pk_bf16(gelu_tanh(g0[2]) * v0[2], gelu_tanh(g0[3]) * v0[3]);
                w.z = cvt_pk_bf16(gelu_tanh(g1[0]) * v1[0], gelu_tanh(g1[1]) * v1[1]); w.w = cvt_pk_bf16(gelu_tanh(g1[2]) * v1[2], gelu_tanh(g1[3]) * v1[3]);
                if (!(ai == 0 && m == 0 && wr == 0 && fr < 2)) *(u32x4*)(G + (size_t)row * DFF + cgb) = w;
                EFENCE();
            }
    }
};

template <class Epi, class Sched, bool ALIGN_EPI = false, bool SP2 = false>
__device__ __forceinline__ void gemm_phase(PG8_LAS unsigned char* lds, const Gemm g, const Sched& S, const Epi& E, int wv) {
    int tid_ = wv * 64 + lane_id_op();
    const int tid = tid_, wid = __builtin_amdgcn_readfirstlane(tid >> 6), lane = tid & 63, wr = wid >> 2, wc = wid & 3, fr = lane & 15, fq = lane >> 4;
    int Kop_ = g.K; if constexpr (!Epi::CONSTK) asm volatile("" : "+s"(Kop_));
    const int K = Kop_, nt = K / BK;
    unsigned voffA[2], voffB[2];
#pragma unroll
    for (int i = 0; i < 2; ++i) { int R, C; stage_rc(tid * 16 + i * 8192, R, C); const int Rb = Epi::PERM ? ((R & ~31) + perm32(R & 31)) : R;
        voffA[i] = (unsigned)(R * K + C) * 2u; voffB[i] = (unsigned)(Rb * K + C) * 2u; }
    const size_t kstep = (size_t)(BK * 2);
    const size_t hstep = (size_t)HALF * K * 2;
    const size_t tstep = 2 * hstep;
    const unsigned ldsw = (unsigned)wid * 1024u;
    const int aoff = lds_byte(wr * 64 + fr, fq * 8), boff = lds_byte(wc * 32 + fr, fq * 8);
#define PG8_SA(b, h) (((b) * 2 + (h)) * HTB)
#define PG8_SB(b, h) ((4 + (b) * 2 + (h)) * HTB)
#define PG8_STAGE(bufoff, gbase, voff) do { _Pragma("unroll") for (int _i = 0; _i < 2; ++_i) \
        __builtin_amdgcn_global_load_lds((const unsigned*)((const char*)(gbase) + (voff)[_i]), (PG8_LAS unsigned*)(lds + (bufoff) + ldsw + _i * 8192), 16, 0, 0); } while (0)
#define PG8_LDA(dst, b, h) do { _Pragma("unroll") for (int m = 0; m < 4; ++m) _Pragma("unroll") for (int k = 0; k < 2; ++k) dst[m][k] = *(const PG8_LAS bf16x8*)(lds + PG8_SA(b, h) + aoff + m * 2048 + k * 1024); } while (0)
#define PG8_LDB(dst, b, h) do { _Pragma("unroll") for (int n = 0; n < 2; ++n) _Pragma("unroll") for (int k = 0; k < 2; ++k) dst[n][k] = *(const PG8_LAS bf16x8*)(lds + PG8_SB(b, h) + boff + n * 2048 + k * 1024); } while (0)
#define PG8_MMA(ai, bj, At, Bt) do { __builtin_amdgcn_s_setprio(1); _Pragma("unroll") for (int m = 0; m < 4; ++m) _Pragma("unroll") for (int n = 0; n < 2; ++n) _Pragma("unroll") for (int k = 0; k < 2; ++k) \
        acc[ai][bj][m][n] = __builtin_amdgcn_mfma_f32_16x16x32_bf16(Bt[n][k], At[m][k], acc[ai][bj][m][n], 0, 0, 0); __builtin_amdgcn_s_setprio(0); } while (0)
#define PG8_WAIT_V(n) asm volatile("s_waitcnt vmcnt(" #n ")" ::: "memory")
#define PG8_WAIT_L(n) asm volatile("s_waitcnt lgkmcnt(" #n ")" ::: "memory")
#define PG8_BAR __builtin_amdgcn_s_barrier()
#define PG8_SCHED __builtin_amdgcn_sched_barrier(0)
    Unit cur, nxt; int ui = 0;
    if (!S.next(0, cur)) return;
    f32x4 acc[2][2][4][2];
#pragma unroll
    for (int a = 0; a < 2; ++a)
#pragma unroll
        for (int b = 0; b < 2; ++b)
#pragma unroll
            for (int m = 0; m < 4; ++m)
#pragma unroll
                for (int n = 0; n < 2; ++n) acc[a][b][m][n] = (f32x4){0.f, 0.f, 0.f, 0.f};
    bf16x8 At[4][2], B0[2][2], B1[2][2];
    const char* cA = (const char*)g.A + (size_t)cur.pm * tstep; const char* cB = (const char*)g.Bt + (size_t)cur.pn * tstep;
    S.a_ready(cur);
    if constexpr (SP2) {
        PG8_STAGE(PG8_SB(0, 0), cB, voffB); PG8_STAGE(PG8_SB(0, 1), cB + hstep, voffB); PG8_STAGE(PG8_SA(0, 0), cA, voffA); PG8_STAGE(PG8_SA(0, 1), cA + hstep, voffA);
        if (wr == 1) PG8_BAR;
        PG8_WAIT_V(2); PG8_BAR;
        PG8_STAGE(PG8_SB(1, 0), cB + kstep, voffB); PG8_STAGE(PG8_SA(1, 0), cA + kstep, voffA); PG8_STAGE(PG8_SB(1, 1), cB + hstep + kstep, voffB);
        PG8_WAIT_V(6); PG8_BAR;
    } else {
        PG8_STAGE(PG8_SB(0, 0), cB, voffB); PG8_STAGE(PG8_SA(0, 0), cA, voffA); PG8_STAGE(PG8_SB(0, 1), cB + hstep, voffB); PG8_STAGE(PG8_SA(0, 1), cA + hstep, voffA);
        if (wr == 1) PG8_BAR;
        PG8_WAIT_V(4); PG8_BAR;
        PG8_STAGE(PG8_SB(1, 0), cB + kstep, voffB); PG8_STAGE(PG8_SA(1, 0), cA + kstep, voffA); PG8_STAGE(PG8_SB(1, 1), cB + hstep + kstep, voffB);
        PG8_WAIT_V(6); PG8_BAR;
    }
    for (;;) {
        const bool has_next = S.next(ui + 1, nxt);
        const char* nA = has_next ? (const char*)g.A + (size_t)nxt.pm * tstep : cA; const char* nB = has_next ? (const char*)g.Bt + (size_t)nxt.pn * tstep : cB;
        for (int t = 0; t < nt; t += 2) {
            const bool last = (t == nt - 2);
            const char* a1 = cA + (size_t)(t + 1) * kstep;
            const char* a2 = last ? nA : cA + (size_t)(t + 2) * kstep; const char* b2 = last ? nB : cB + (size_t)(t + 2) * kstep;
            const char* a3 = a2 + kstep; const char* b3 = b2 + kstep;
            if (last && has_next) S.a_ready(nxt);
            if constexpr (SP2) {
            PG8_LDB(B0, 0, 0); PG8_LDB(B1, 0, 1); PG8_SCHED; PG8_LDA(At, 0, 0); PG8_STAGE(PG8_SA(1, 1), a1 + hstep, voffA);
            PG8_WAIT_V(8); PG8_WAIT_L(0); PG8_BAR; PG8_MMA(0, 0, At, B0); PG8_MMA(0, 1, At, B1); PG8_BAR; PG8_SCHED;
            PG8_LDA(At, 0, 1); PG8_STAGE(PG8_SB(0, 0), b2, voffB); PG8_STAGE(PG8_SB(0, 1), b2 + hstep, voffB); PG8_STAGE(PG8_SA(0, 0), a2, voffA);
            PG8_WAIT_V(8); PG8_WAIT_L(0); PG8_BAR; PG8_MMA(1, 0, At, B0); PG8_MMA(1, 1, At, B1); PG8_BAR; PG8_SCHED;
            PG8_LDB(B0, 1, 0); PG8_LDB(B1, 1, 1); PG8_SCHED; PG8_LDA(At, 1, 0); PG8_STAGE(PG8_SA(0, 1), a2 + hstep, voffA);
            PG8_WAIT_V(8); PG8_WAIT_L(0); PG8_BAR; PG8_MMA(0, 0, At, B0); PG8_MMA(0, 1, At, B1); PG8_BAR; PG8_SCHED;
            PG8_LDA(At, 1, 1); PG8_STAGE(PG8_SB(1, 0), b3, voffB); PG8_STAGE(PG8_SB(1, 1), b3 + hstep, voffB); PG8_STAGE(PG8_SA(1, 0), a3, voffA);
            PG8_WAIT_V(8); PG8_WAIT_L(0); PG8_BAR; PG8_MMA(1, 0, At, B0); PG8_MMA(1, 1, At, B1); PG8_BAR; PG8_SCHED;
            } else {
            PG8_LDB(B0, 0, 0); PG8_SCHED; PG8_LDA(At, 0, 0); PG8_STAGE(PG8_SA(1, 1), a1 + hstep, voffA);
            PG8_WAIT_L(8); PG8_BAR; PG8_WAIT_L(0); PG8_MMA(0, 0, At, B0); PG8_BAR; PG8_SCHED;
            PG8_LDB(B1, 0, 1); PG8_STAGE(PG8_SB(0, 0), b2, voffB);
            PG8_BAR; PG8_WAIT_L(0); PG8_MMA(0, 1, At, B1); PG8_BAR;
            PG8_LDA(At, 0, 1); PG8_STAGE(PG8_SA(0, 0), a2, voffA);
            PG8_BAR; PG8_WAIT_L(0); PG8_MMA(1, 0, At, B0); PG8_BAR; PG8_SCHED;
            PG8_STAGE(PG8_SB(0, 1), b2 + hstep, voffB);
            PG8_WAIT_V(6); PG8_BAR; PG8_MMA(1, 1, At, B1); PG8_BAR;
            PG8_LDB(B0, 1, 0); PG8_SCHED; PG8_LDA(At, 1, 0); PG8_STAGE(PG8_SA(0, 1), a2 + hstep, voffA);
            PG8_WAIT_L(8); PG8_BAR; PG8_WAIT_L(0); PG8_MMA(0, 0, At, B0); PG8_BAR; PG8_SCHED;
            PG8_LDB(B1, 1, 1); PG8_STAGE(PG8_SB(1, 0), b3, voffB);
            PG8_BAR; PG8_WAIT_L(0); PG8_MMA(0, 1, At, B1); PG8_BAR;
            PG8_LDA(At, 1, 1); PG8_STAGE(PG8_SA(1, 0), a3, voffA);
            PG8_BAR; PG8_WAIT_L(0); PG8_MMA(1, 0, At, B0); PG8_BAR; PG8_SCHED;
            PG8_STAGE(PG8_SB(1, 1), b3 + hstep, voffB);
            PG8_WAIT_V(6); PG8_BAR; PG8_MMA(1, 1, At, B1); PG8_BAR;
            }
        }
        if constexpr (ALIGN_EPI) { if (wr == 0) PG8_BAR; }
        if constexpr (!Epi::AFTER_DRAIN) { E(acc, cur, wr, wc, fr, fq); S.done(cur); }
        if (!has_next) break;
#pragma unroll
        for (int a = 0; a < 2; ++a)
#pragma unroll
            for (int b = 0; b < 2; ++b)
#pragma unroll
                for (int m = 0; m < 4; ++m)
#pragma unroll
                    for (int n = 0; n < 2; ++n) acc[a][b][m][n] = (f32x4){0.f, 0.f, 0.f, 0.f};
        cur = nxt; cA = nA; cB = nB; ++ui;
        if constexpr (ALIGN_EPI) { if (wr == 1) PG8_BAR; }
    }
    PG8_WAIT_V(0);
    if constexpr (!ALIGN_EPI) { if (wr == 0) PG8_BAR; }
    PG8_BAR;
    if constexpr (Epi::AFTER_DRAIN) { E.fused(acc, cur, wr, wc, fr, fq, lds, wid, lane); S.done(cur); }
#undef PG8_SA
#undef PG8_SB
#undef PG8_STAGE
#undef PG8_LDA
#undef PG8_LDB
#undef PG8_MMA
#undef PG8_WAIT_V
#undef PG8_WAIT_L
#undef PG8_BAR
#undef PG8_SCHED
}
}
#define LAS __attribute__((address_space(3)))
typedef unsigned short bf16;
typedef short bf16x8 __attribute__((ext_vector_type(8)));
typedef short s16x4 __attribute__((ext_vector_type(4)));
typedef float f32x4 __attribute__((ext_vector_type(4)));
typedef float f32x16 __attribute__((ext_vector_type(16)));
typedef unsigned u32x4 __attribute__((ext_vector_type(4)));
typedef unsigned u32x2 __attribute__((ext_vector_type(2)));
typedef float fl2 __attribute__((ext_vector_type(2)));
__device__ __forceinline__ fl2 mk2(float x, float y) { fl2 r; r.x = x; r.y = y; return r; }
using pg8::cvt_pk_bf16; using pg8::gelu_tanh; using pg8::bflo; using pg8::bfhi; using pg8::f2bf1;


#define XB_TMO      128
#define XB_XCNT(j)  (256  + 64 * (j))
#define XB_XSUB(j)  (1280 + 64 * (j))
#define XB_XGEN(j)  (2304 + 64 * (j))
#define XB_TOP      3328
#define XB_TOPGEN   3392
#define XCD_BAR_WORDS 3456
#define XB_SPIN_CAP (1u << 18)

__device__ __forceinline__ unsigned xb_ld(unsigned* p)              { return __hip_atomic_load(p, __ATOMIC_RELAXED, __HIP_MEMORY_SCOPE_AGENT); }
__device__ __forceinline__ unsigned xb_add(unsigned* p, unsigned v) { return __hip_atomic_fetch_add(p, v, __ATOMIC_RELAXED, __HIP_MEMORY_SCOPE_AGENT); }
__device__ __forceinline__ unsigned xb_xcc_id() { return (unsigned)__builtin_amdgcn_s_getreg((3 << 11) | 20) & 0xFu; }
#define XB_SPIN(cond, bar) do { unsigned _sp = 0; while (cond) { __builtin_amdgcn_s_sleep(1); \
    if ((++_sp & 255u) == 0u) { if (xb_ld(&(bar)[XB_TMO])) break; if (_sp > XB_SPIN_CAP) { atomicAdd(&(bar)[XB_TMO], 1u); break; } } } } while (0)

struct XcdBarrier {
    unsigned* bar; unsigned x;
    volatile LAS unsigned* st;
};

__device__ __forceinline__ XcdBarrier xcd_barrier_post(unsigned* bar, volatile LAS unsigned* st, bool leader) {
    XcdBarrier b; b.bar = bar; b.x = xb_xcc_id(); b.st = st;
    if (leader) (void)xb_add(&bar[XB_XCNT(b.x)], 1u);
    return b;
}
__device__ __forceinline__ void xcd_barrier_complete(unsigned* bar, unsigned x, unsigned& nloc, unsigned& nx) {
    const unsigned G = gridDim.x * gridDim.y * gridDim.z;
    unsigned sum, cnt, mine, sp = 0u;
    for (;;) {
        sum = 0u; cnt = 0u; mine = 0u;
#pragma unroll
        for (unsigned j = 0; j < 16; ++j) { const unsigned c = xb_ld(&bar[XB_XCNT(j)]); sum += c; cnt += (c > 0u) ? 1u : 0u; mine = (j == x) ? c : mine; }
        if (sum == G) break;
        __builtin_amdgcn_s_sleep(1);
        if ((++sp & 255u) == 0u) { if (xb_ld(&bar[XB_TMO])) break; if (sp > XB_SPIN_CAP) { atomicAdd(&bar[XB_TMO], 1u); break; } }
    }
    nloc = mine > 0u ? mine : 1u; nx = cnt > 0u ? cnt : 1u;
}

__device__ __forceinline__ void xcd_barrier(const XcdBarrier& b, bool leader) {
    asm volatile("s_waitcnt vmcnt(0)" ::: "memory");
    __syncthreads();
    if (leader) {
        unsigned* bar = b.bar;
        __builtin_amdgcn_s_waitcnt(0);
        unsigned nloc = b.st[0], nx = b.st[1];
        if (nloc == 0u) { xcd_barrier_complete(bar, b.x, nloc, nx); b.st[0] = nloc; b.st[1] = nx; }
        const unsigned old = xb_add(&bar[XB_XSUB(b.x)], 1u);
        const unsigned gen = old / nloc;
        if (old + 1u == (gen + 1u) * nloc) {
            __builtin_amdgcn_fence(__ATOMIC_RELEASE, "agent");
            asm volatile("s_waitcnt vmcnt(0)" ::: "memory");
            const unsigned og = xb_add(&bar[XB_TOP], 1u);
            const unsigned tg = og / nx;
            if (og + 1u == (tg + 1u) * nx) xb_add(&bar[XB_TOPGEN], 1u);
            else XB_SPIN(xb_ld(&bar[XB_TOPGEN]) == tg, bar);
            __builtin_amdgcn_fence(__ATOMIC_ACQUIRE, "agent");
            xb_add(&bar[XB_XGEN(b.x)], 1u);
            asm volatile("s_waitcnt vmcnt(0)" ::: "memory");
        } else {
            XB_SPIN(xb_ld(&bar[XB_XGEN(b.x)]) == gen, bar);
            __builtin_amdgcn_fence(__ATOMIC_ACQUIRE, "agent");
            asm volatile("s_waitcnt vmcnt(0)" ::: "memory");
        }
    }
    __syncthreads();
}

#ifndef EN_MASK
#define EN_MASK 0x1ff
#endif
#ifndef PROBE_CE
#define PROBE_CE 0
#endif
#ifndef REP_MASK
#define REP_MASK 0
#endif
#define REPS(bit) for (int rep_ = 0; rep_ <= ((REP_MASK >> (bit)) & 1); ++rep_)
#define EN_P ((EN_MASK>>0)&1)
#define EN_A ((EN_MASK>>1)&1)
#define EN_S5 ((EN_MASK>>2)&1)
#define EN_ATT ((EN_MASK>>3)&1)
#define EN_SGU ((EN_MASK>>4)&1)
#define EN_G ((EN_MASK>>5)&1)
#define EN_C ((EN_MASK>>6)&1)
#define EN_D ((EN_MASK>>7)&1)
#define EN_E ((EN_MASK>>8)&1)
struct Args { const float* in[29]; float* out; unsigned char* ws; int ph_lo, ph_hi; };
typedef const Args __attribute__((address_space(4))) CArgs;
__device__ __forceinline__ CArgs* argp() { CArgs* p = (CArgs*)__builtin_amdgcn_kernarg_segment_ptr(); asm volatile("" : "+s"(p)); return p; }

__device__ __forceinline__ int otid(int wv) { return wv * 64 + pg8::lane_id_op(); }
__device__ __forceinline__ float wave_sum(float v) { return pg8::wave_sum64(v); }
__device__ __forceinline__ unsigned pk2(float lo, float hi) { return cvt_pk_bf16(lo, hi); }
#define EFENCE() do { asm volatile("" ::: "memory"); __builtin_amdgcn_sched_barrier(0); } while (0)
#define LDS_WAIT() asm volatile("s_waitcnt lgkmcnt(0)" ::: "memory")
#define WG_BAR() do { asm volatile("s_waitcnt vmcnt(0) lgkmcnt(0)" ::: "memory"); __builtin_amdgcn_s_barrier(); asm volatile("" ::: "memory"); } while (0)

__device__ __forceinline__ void sincos_rev(double ang, float& c, float& s) {
    const double rev = ang * 0.15915494309189535; const float f = (float)(rev - __builtin_rint(rev));
    c = __builtin_amdgcn_cosf(f); s = __builtin_amdgcn_sinf(f);
}

__device__ __forceinline__ void tr_item(const float* W, int Nsrc, int k0, int nsrc0, const float* gain, bf16* WT, int K, int ndst0, LAS float* scr, int lane) {
    float wv_[32];
#pragma unroll
    for (int i = 0; i < 32; ++i) wv_[i] = W[(size_t)(k0 + 2 * i + (lane >> 5)) * Nsrc + nsrc0 + (lane & 31)];
#pragma unroll
    for (int i = 0; i < 32; ++i) { const int kk = 2 * i + (lane >> 5); const float g = gain ? gain[k0 + kk] : 1.0f; scr[kk * 33 + (lane & 31)] = wv_[i] * g; }
    LDS_WAIT(); asm volatile("" ::: "memory");
    const int c = lane & 7;
#pragma unroll
    for (int j = 0; j < 4; ++j) { const int n = (lane >> 3) + 8 * j; const LAS float* s = scr + (8 * c) * 33 + n;
        u32x4 o; o.x = pk2(s[0 * 33], s[1 * 33]); o.y = pk2(s[2 * 33], s[3 * 33]); o.z = pk2(s[4 * 33], s[5 * 33]); o.w = pk2(s[6 * 33], s[7 * 33]);
        __builtin_nontemporal_store(o, (u32x4*)(WT + (size_t)(ndst0 + n) * K + k0 + 8 * c)); }
    LDS_WAIT(); asm volatile("" ::: "memory");
}

__device__ __forceinline__ void s5_tables(LAS unsigned char* lds, int l, int g, int part, int wv) {
    CArgs& a = *argp();
    const int tid = otid(wv);
    LAS fl2* apw = (LAS fl2*)lds;
    LAS fl2* bbL = (LAS fl2*)(lds + 65 * 64 * 8);
    LAS fl2* cL = bbL + 64 * 16;
    const int lg = l * 16 + g;
    const float dt = __expf(a.in[5][lg]);
    { const int p = tid & 63; const float are = a.in[3][lg * 64 + p], aim = a.in[4][lg * 64 + p];
      for (int j = tid >> 6; j <= 64; j += 8) { const float mag = __expf(are * dt * (float)j); float c, s; sincos_rev((double)(aim * dt) * (double)j, c, s); apw[j * 64 + p] = mk2(mag * c, mag * s); } }
    for (int i = tid; i < 1024; i += 512) { const int h = i >> 6, p = i & 63; cL[h * 64 + p] = mk2(a.in[8][(size_t)lg * 1024 + h * 64 + p], a.in[9][(size_t)lg * 1024 + h * 64 + p]); }
    WG_BAR();
    for (int i = tid; i < 1024; i += 512) { const int p = i >> 4, h = i & 15;
        const float are = a.in[3][lg * 64 + p], aim = a.in[4][lg * 64 + p]; const fl2 ab = apw[64 + p];
        const float nr = ab.x - 1.0f, ni = ab.y, den = 1.0f / (are * are + aim * aim);
        const float qr = (nr * are + ni * aim) * den, qi = (ni * are - nr * aim) * den;
        const float br = a.in[6][(size_t)lg * 1024 + p * 16 + h], bi = a.in[7][(size_t)lg * 1024 + p * 16 + h];
        bbL[p * 16 + h] = mk2(qr * br - qi * bi, qr * bi + qi * br); }
    if (tid < 64 && part == 0) { const fl2 v = apw[64 * 64 + tid]; ((fl2*)(a.ws + WS_A64))[lg * 64 + tid] = v; }
    WG_BAR();
    bf16* KT = (bf16*)(a.ws + WS_KTAB) + (size_t)lg * 16384;
    for (int idx = tid + part * 4096; idx < (part + 1) * 4096; idx += 512) { const int j = idx >> 8, hp = (idx >> 4) & 15, h = idx & 15; float acc = 0.f;
        for (int p = 0; p < 64; ++p) { const fl2 c = cL[hp * 64 + p], ap = apw[j * 64 + p], b = bbL[p * 16 + h];
            const float tr = c.x * ap.x - c.y * ap.y, ti = c.x * ap.y + c.y * ap.x; acc += tr * b.x - ti * b.y; }
        KT[idx] = f2bf1(acc); }
    bf16* BP = (bf16*)(a.ws + WS_BPOW) + (size_t)lg * 131072;
    for (int idx = tid + part * 32768; idx < (part + 1) * 32768; idx += 512) { const int n = idx >> 10, k = idx & 1023, p = n & 63, t = k >> 4, h = k & 15;
        const fl2 ap = apw[(63 - t) * 64 + p], b = bbL[p * 16 + h];
        BP[idx] = f2bf1(n < 64 ? (ap.x * b.x - ap.y * b.y) : (ap.x * b.y + ap.y * b.x)); }
    bf16* CP = (bf16*)(a.ws + WS_CPOW) + (size_t)lg * 131072;
    for (int idx = tid + part * 32768; idx < (part + 1) * 32768; idx += 512) { const int n = idx >> 7, k = idx & 127, p = k & 63, t = n >> 4, hp = n & 15;
        const fl2 ap = apw[(t + 1) * 64 + p], c = cL[hp * 64 + p];
        CP[idx] = f2bf1(k < 64 ? (c.x * ap.x - c.y * ap.y) : -(c.x * ap.y + c.y * ap.x)); }
    WG_BAR();
}

__device__ __forceinline__ void prologue(LAS unsigned char* lds, int wv) {
    CArgs& a = *argp();
    const int tid = otid(wv), lane = tid & 63, wave = __builtin_amdgcn_readfirstlane(tid >> 6);
    const int G = gridDim.x, bx = blockIdx.x;
    const int gt = bx * 512 + tid, NT = G * 512;
    { fl2* R = (fl2*)(a.ws + WS_ROPE);
      for (int i = gt; i < 4096 * 32; i += NT) { const int s = i >> 5, j = i & 31; const float inv = exp2f(-(float)j * (13.287712379549449f / 32.0f)); const float ang = (float)s * inv; float c, sn; sincos_rev((double)ang, c, sn); R[i] = mk2(c, sn); } }
    { bf16* WSB = (bf16*)(a.ws + WS_WSB);
      for (int i = gt; i < 4 * 4 * 128 * 128; i += NT) { const int ii = (i >> 7) & 127, jj = i & 127; WSB[i] = ((jj >> 6) <= (ii >> 6)) ? f2bf1(a.in[14][i]) : (bf16)0; } }
    if (bx == 0 && wave < 4) { const int l = wave; const float d1 = wave_sum(a.in[18][l * 64 + lane] * a.in[19][l * 64 + lane]), d2 = wave_sum(a.in[20][l * 64 + lane] * a.in[21][l * 64 + lane]);
        if (lane == 0) ((float*)(a.ws + WS_MISC))[l] = __expf(d1) - __expf(d2) + (0.8f - 0.6f * __expf(-0.3f * (float)l)); }
    for (int t = bx; t < 256; t += G) s5_tables(lds, t >> 6, (t >> 2) & 15, t & 3, wv);
    LAS float* scr = (LAS float*)(lds + wave * 16384);
    const int gw = bx * 8 + wave, NGW = G * 8;
    for (int it = gw; it < 4 * 5920; it += NGW) {
        const int l = it / 5920; int r = it % 5920;
        if (r < 1152) { const int kb = r / 72, gi = r % 72, nd = 32 * gi, pn = nd >> 8, p = nd & 255; int src = nd;
            if (pn >= 3 && pn < 7) { const int bj = p >> 7, wc = (p & 127) >> 5, tq = (pn - 3) & 1; src = (pn < 5 ? 768 : 1280) + (4 * tq + wc) * 64 + 32 * bj; }
            tr_item(a.in[2] + (size_t)l * 1024 * 2304, 2304, 64 * kb, src, a.in[1] + l * 1024, (bf16*)(a.ws + WS_WIN) + (size_t)l * 2304 * 1024, 1024, nd, scr, lane); continue; }
        r -= 1152;
        if (r < 512) { const int kb = r / 32, gi = r % 32; tr_item(a.in[23] + (size_t)l * 1024 * 1024, 1024, 64 * kb, 32 * gi, nullptr, (bf16*)(a.ws + WS_WOUT) + (size_t)l * 1024 * 1024, 1024, 32 * gi, scr, lane); continue; }
        r -= 512;
        if (r < 2816) { const int kb = r / 176, gi = r % 176, nd = 32 * gi, pn = nd >> 8, p = nd & 255, bj = p >> 7, jp = p & 127;
            tr_item(a.in[25] + (size_t)l * 1024 * 5632, 5632, 64 * kb, bj * 2816 + 128 * pn + jp, a.in[24] + l * 1024, (bf16*)(a.ws + WS_WUP) + (size_t)l * 5632 * 1024, 1024, nd, scr, lane); continue; }
        r -= 2816;
        if (r < 1408) { const int kb = r / 32, gi = r % 32; tr_item(a.in[28] + (size_t)l * 2816 * 1024, 1024, 64 * kb, 32 * gi, nullptr, (bf16*)(a.ws + WS_WDN) + (size_t)l * 1024 * 2816, 2816, 32 * gi, scr, lane); continue; }
        r -= 1408;
        { const int kb = r / 8, gi = r % 8; tr_item(a.in[11] + (size_t)l * 256 * 256, 256, 64 * kb, 32 * gi, nullptr, (bf16*)(a.ws + WS_WGLU) + (size_t)l * 256 * 256, 256, 32 * gi, scr, lane); }
    }
    { float* ssq0 = (float*)(a.ws + WS_SSQ); bf16* HB = (bf16*)(a.ws + WS_HB);
      for (int m0 = gw * 4; m0 < MTOK; m0 += NGW * 4) { f32x4 v[4][4];
#pragma unroll
          for (int r = 0; r < 4; ++r) { const f32x4* xr = (const f32x4*)(a.in[0] + (size_t)(m0 + r) * 1024) + lane;
#pragma unroll
              for (int j = 0; j < 4; ++j) v[r][j] = xr[64 * j]; }
#pragma unroll
          for (int r = 0; r < 4; ++r) { float s = 0.f;
#pragma unroll
              for (int j = 0; j < 4; ++j) s += (v[r][j][0] * v[r][j][0] + v[r][j][1] * v[r][j][1]) + (v[r][j][2] * v[r][j][2] + v[r][j][3] * v[r][j][3]);
              s = wave_sum(s); if (lane < 4) ssq0[(size_t)(m0 + r) * 4 + lane] = (lane == 0) ? s : 0.f;
              u32x2* o8 = (u32x2*)(HB + (size_t)(m0 + r) * 1024) + lane;
#pragma unroll
              for (int j = 0; j < 4; ++j) { u32x2 w; w.x = pk2(v[r][j][0], v[r][j][1]); w.y = pk2(v[r][j][2], v[r][j][3]); o8[64 * j] = w; } } } }
}

__device__ __forceinline__ void glds16(const void* gsrc, unsigned lds_dst) { unsigned keep;
    asm volatile("s_mov_b32 %0, m0\n\ts_mov_b32 m0, %2\n\ts_nop 0\n\tglobal_load_lds_dwordx4 %1, off\n\ts_mov_b32 m0, %0" : "=&s"(keep) : "v"(gsrc), "s"(lds_dst) : "memory"); }
__device__ __forceinline__ void attn_unit(LAS unsigned char* lds, const bf16* QB, const bf16* KB, const bf16* VT, bf16* MIX, const float* subg, float lam, float omli, int b, int head, int qb, int wv) {
    const int tid = otid(wv), lane = tid & 63, w = __builtin_amdgcn_readfirstlane(tid >> 6), r32 = lane & 31, hi = lane >> 5;
    const int c = w >> 2, qi = w & 3;
    const int NT = 2 * qb + 2, qchunk = 2 * qb + (qi >> 1);
    const size_t bh = (size_t)(b * 4 + head);
    const bf16* Qp = QB + ((bh * 2 + c) * 4096 + qb * 128 + qi * 32 + r32) * 64;
    bf16x8 qr[4];
#pragma unroll
    for (int d0 = 0; d0 < 4; ++d0) qr[d0] = *(const bf16x8*)(Qp + d0 * 16 + hi * 8);
    asm volatile("" : "+v"(qr[0]), "+v"(qr[1]), "+v"(qr[2]), "+v"(qr[3]));
    constexpr int KSLOT = 16384, VBASE = 3 * KSLOT, VSLOT = 16384;
    const unsigned lds0 = (unsigned)(uintptr_t)lds;
    const int drow = 8 * w + (lane >> 3), dsw = (drow ^ (drow >> 3)) & 7, dch = ((lane & 7) ^ dsw) * 8;
    const bf16* ksrc0 = KB + (bh * 2) * 4096 * 64 + (size_t)drow * 64 + dch; const bf16* ksrc1 = ksrc0 + 4096 * 64;
    const bf16* vsrcA = VT + bh * 128 * 4096 + (size_t)drow * 64 + dch; const bf16* vsrcB = vsrcA + (size_t)64 * 64;
#define A_DMA(j, ks, vs) do { const unsigned kd_ = (unsigned)__builtin_amdgcn_readfirstlane(lds0 + (ks) * KSLOT + w * 1024), vd_ = (unsigned)__builtin_amdgcn_readfirstlane(lds0 + VBASE + (vs) * VSLOT + w * 1024); \
        glds16(ksrc0 + (size_t)(j) * 4096, kd_); glds16(ksrc1 + (size_t)(j) * 4096, kd_ + 8192); glds16(vsrcA + (size_t)(j) * 8192, vd_); glds16(vsrcB + (size_t)(j) * 8192, vd_ + 8192); } while (0)
    const int sw16 = ((r32 ^ (r32 >> 3)) & 7) * 16;
    const int kA = c * 8192 + r32 * 128 + ((hi * 16) ^ sw16), kB = c * 8192 + (r32 + 32) * 128 + ((hi * 16) ^ sw16 ^ 64);
    int vA[4];
#pragma unroll
    for (int i = 0; i < 4; ++i) vA[i] = (32 * i + r32) * 128 + ((hi * 16) ^ sw16 ^ ((i & 1) * 64));
    f32x16 o[4];
#pragma unroll
    for (int i = 0; i < 4; ++i) o[i] = f32x16{};
    float m_run = -1e30f, l_run = 0.f;
    bf16x8 pa[4];
#pragma unroll
    for (int i = 0; i < 4; ++i) pa[i] = (bf16x8){0, 0, 0, 0, 0, 0, 0, 0};
#define SB() __builtin_amdgcn_sched_barrier(0)
#define QK_TILE(P0, P1, ks_) do { \
        const LAS unsigned char* kb = lds + (ks_) * KSLOT; \
        bf16x8 kc0 = *(const LAS bf16x8*)(kb + kA), kc1 = *(const LAS bf16x8*)(kb + kB); \
        _Pragma("unroll") for (int d0 = 0; d0 < 4; ++d0) { \
            bf16x8 kn0 = kc0, kn1 = kc1; \
            if (d0 < 3) { kn0 = *(const LAS bf16x8*)(kb + (kA ^ (32 * (d0 + 1)))); kn1 = *(const LAS bf16x8*)(kb + (kB ^ (32 * (d0 + 1)))); } \
            SB(); \
            if (d0 == 0) { P0 = __builtin_amdgcn_mfma_f32_32x32x16_bf16(kc0, qr[0], f32x16{}, 0, 0, 0); P1 = __builtin_amdgcn_mfma_f32_32x32x16_bf16(kc1, qr[0], f32x16{}, 0, 0, 0); } \
            else { P0 = __builtin_amdgcn_mfma_f32_32x32x16_bf16(kc0, qr[d0], P0, 0, 0, 0); P1 = __builtin_amdgcn_mfma_f32_32x32x16_bf16(kc1, qr[d0], P1, 0, 0, 0); } \
            SB(); \
            kc0 = kn0; kc1 = kn1; } } while (0)
#define ROWMAX(MX, P0, P1) do { MX = fmaxf(P0[0], P1[0]); _Pragma("unroll") for (int r = 1; r < 16; ++r) MX = fmaxf(fmaxf(MX, P0[r]), P1[r]); MX = pg8::xmax32(MX); } while (0)
#define PACK4(DST, P, B) do { u32x4 t_; t_.x = pk2(P[B], P[B + 1]); t_.y = pk2(P[B + 2], P[B + 3]); t_.z = pk2(P[B + 4], P[B + 5]); t_.w = pk2(P[B + 6], P[B + 7]); DST = __builtin_bit_cast(bf16x8, t_); } while (0)
#define PV_FRAG(dst, ks_) do { _Pragma("unroll") for (int i_ = 0; i_ < 4; ++i_) dst[i_] = *(const LAS bf16x8*)(vb + (vA[i_] ^ (32 * (ks_)))); } while (0)
#define PV_GROUP(ks_) do { _Pragma("unroll") for (int i_ = 0; i_ < 4; ++i_) o[i_] = __builtin_amdgcn_mfma_f32_32x32x16_bf16(vc[i_], pa[ks_], o[i_], 0, 0, 0); } while (0)
#define WAIT_BAR(N) asm volatile("s_waitcnt vmcnt(" #N ") lgkmcnt(0)\n\ts_barrier" ::: "memory")
    A_DMA(0, 0, 0); A_DMA(1, 1, 1);
    if (NT > 2) { A_DMA(2, 2, 2); WAIT_BAR(8); } else { WAIT_BAR(4); }
    {
        f32x16 p0, p1; QK_TILE(p0, p1, 0);
        float mx; ROWMAX(mx, p0, p1); m_run = mx;
        p0 = p0 - m_run; p1 = p1 - m_run; float ps = 0.f;
#pragma unroll
        for (int r = 0; r < 16; ++r) { p0[r] = __builtin_amdgcn_exp2f(p0[r]); p1[r] = __builtin_amdgcn_exp2f(p1[r]); ps += p0[r] + p1[r]; }
        l_run = ps;
        PACK4(pa[0], p0, 0); PACK4(pa[1], p0, 8); PACK4(pa[2], p1, 0); PACK4(pa[3], p1, 8);
    }
    if (NT > 2) { WAIT_BAR(4); } else { WAIT_BAR(0); }
    int kn = 1, vcur = 0;
#pragma unroll 1
    for (int j = 0; j < NT; ++j) {
        if (j + 3 < NT) { const int k3 = kn == 0 ? 2 : kn - 1, v3 = vcur == 0 ? 3 : vcur - 1; A_DMA(j + 3, k3, v3); }
        const bool doPV = j <= qchunk, doQK = (j + 1 <= qchunk);
        if (doPV) {
            const LAS unsigned char* vb = lds + VBASE + vcur * VSLOT;
            bf16x8 vc[4], vn[4];
            if (doQK) {
                f32x16 p0, p1; QK_TILE(p0, p1, kn);
                PV_FRAG(vc, 0); PV_FRAG(vn, 1); SB();
                PV_GROUP(0);
                float mx; ROWMAX(mx, p0, p1);
                float alpha = 1.0f; bool resc = false;
                if (__any(mx > m_run + 6.0f)) { const float mn = fmaxf(mx, m_run); alpha = __builtin_amdgcn_exp2f(m_run - mn); m_run = mn; resc = true; }
                SB();
#pragma unroll
                for (int i = 0; i < 4; ++i) vc[i] = vn[i];
                PV_FRAG(vn, 2); SB();
                PV_GROUP(1);
                p0 = p0 - m_run;
#pragma unroll
                for (int r = 0; r < 16; ++r) p0[r] = __builtin_amdgcn_exp2f(p0[r]);
                SB();
#pragma unroll
                for (int i = 0; i < 4; ++i) vc[i] = vn[i];
                PV_FRAG(vn, 3); SB();
                PV_GROUP(2);
                p1 = p1 - m_run;
#pragma unroll
                for (int r = 0; r < 16; ++r) p1[r] = __builtin_amdgcn_exp2f(p1[r]);
                SB();
#pragma unroll
                for (int i = 0; i < 4; ++i) vc[i] = vn[i];
                SB();
                PV_GROUP(3);
                float ps = 0.f;
#pragma unroll
                for (int r = 0; r < 16; ++r) ps += p0[r] + p1[r];
                bf16x8 pn[4]; PACK4(pn[0], p0, 0); PACK4(pn[1], p0, 8); PACK4(pn[2], p1, 0); PACK4(pn[3], p1, 8);
                SB();
                if (resc) { l_run *= alpha;
#pragma unroll
                    for (int i = 0; i < 4; ++i) o[i] = o[i] * alpha; }
                l_run += ps;
#pragma unroll
                for (int i = 0; i < 4; ++i) pa[i] = pn[i];
            } else {
                PV_FRAG(vc, 0);
#pragma unroll
                for (int ks = 0; ks < 4; ++ks) { if (ks < 3) PV_FRAG(vn, ks + 1); SB(); PV_GROUP(ks); SB();
#pragma unroll
                    for (int i = 0; i < 4; ++i) vc[i] = vn[i]; }
            }
        }
        kn = kn == 2 ? 0 : kn + 1; vcur = vcur == 3 ? 0 : vcur + 1;
        if (j + 3 < NT) WAIT_BAR(4); else WAIT_BAR(0);
    }
#undef A_DMA
#undef QK_TILE
#undef ROWMAX
#undef PACK4
#undef PV_FRAG
#undef PV_GROUP
#undef WAIT_BAR
#undef SB
    l_run = pg8::xsum32(l_run);
    const float inv = 1.0f / l_run;
    LAS float* xo = (LAS float*)lds + (size_t)(qi * 32 + r32) * 132;
    if (c == 1) {
#pragma unroll
        for (int i = 0; i < 4; ++i)
#pragma unroll
            for (int q4 = 0; q4 < 4; ++q4) { f32x4 v = {o[i][4 * q4] * inv, o[i][4 * q4 + 1] * inv, o[i][4 * q4 + 2] * inv, o[i][4 * q4 + 3] * inv}; *(LAS f32x4*)(xo + 32 * i + 8 * q4 + 4 * hi) = v; }
    }
    WG_BAR();
    if (c == 0) {
        float ss = 0.f;
#pragma unroll
        for (int i = 0; i < 4; ++i)
#pragma unroll
            for (int q4 = 0; q4 < 4; ++q4) { const f32x4 v = *(const LAS f32x4*)(xo + 32 * i + 8 * q4 + 4 * hi);
#pragma unroll
                for (int e = 0; e < 4; ++e) { const float d = o[i][4 * q4 + e] * inv - lam * v[e]; o[i][4 * q4 + e] = d; ss += d * d; } }
        ss = pg8::xsum32(ss);
        const float rn = rsqrtf(ss * (1.0f / 128.0f) + 1e-6f) * omli;
        bf16* dst = MIX + ((size_t)b * 4096 + qb * 128 + qi * 32 + r32) * 1024 + 512 + head * 128;
#pragma unroll
        for (int i = 0; i < 4; ++i)
#pragma unroll
            for (int q4 = 0; q4 < 4; ++q4) { const int dv = 32 * i + 8 * q4 + 4 * hi; const f32x4 g = *(const f32x4*)(subg + dv);
                u32x2 wv2; wv2.x = pk2(o[i][4 * q4] * rn * g[0], o[i][4 * q4 + 1] * rn * g[1]); wv2.y = pk2(o[i][4 * q4 + 2] * rn * g[2], o[i][4 * q4 + 3] * rn * g[3]);
                *(u32x2*)(dst + dv) = wv2; }
    }
    WG_BAR();
}

__device__ __forceinline__ void s5_unit(LAS unsigned char* lds, int l, int b, int g, int hs, int wv) {
    CArgs& a = *argp();
    const int tid = otid(wv), lane = tid & 63, w = __builtin_amdgcn_readfirstlane(tid >> 6), fr = lane & 15, fq = lane >> 4;
    const int lg = l * 16 + g;
    const bf16* U = (const bf16*)(a.ws + WS_US) + ((size_t)g * MTOK + (size_t)b * 4096) * 16;
    const bf16* BP = (const bf16*)(a.ws + WS_BPOW) + (size_t)lg * 131072;
    const bf16* CP = (const bf16*)(a.ws + WS_CPOW) + (size_t)lg * 131072;
    const bf16* KT = (const bf16*)(a.ws + WS_KTAB) + (size_t)lg * 16384;
    LAS float* Ef = (LAS float*)lds;
    LAS bf16* Xs = (LAS bf16*)(lds + 32768);
    LAS bf16* KL = (LAS bf16*)(lds + 65536);
    { const u32x4* src = (const u32x4*)KT; LAS u32x4* dst = (LAS u32x4*)KL;
#pragma unroll
      for (int i = 0; i < 4; ++i) dst[tid + 512 * i] = src[tid + 512 * i]; }
    LAS unsigned char* CH = lds + 98304;
    const int srow0 = tid >> 4, sseg = tid & 15;
    const bf16* Ust = U + (size_t)srow0 * 1024 + sseg * 8;
    LAS unsigned char* CHst = CH + srow0 * 272 + sseg * 16;
    const LAS unsigned char* CHrd = CH + fr * 272 + fq * 16;
    u32x4 sg0, sg1;
#define S5_GLOAD(kg) do { sg0 = *(const u32x4*)(Ust + 128 * (kg)); sg1 = *(const u32x4*)(Ust + 32 * 1024 + 128 * (kg)); } while (0)
#define S5_GSTORE(buf) do { *(LAS u32x4*)(CHst + (buf) * 17408) = sg0; *(LAS u32x4*)(CHst + (buf) * 17408 + 32 * 272) = sg1; } while (0)
#define S5_LDA(dst, buf, q) do { _Pragma("unroll") for (int m_ = 0; m_ < 4; ++m_) dst[m_] = *(const LAS bf16x8*)(CHrd + (buf) * 17408 + m_ * 16 * 272 + (q) * 64); } while (0)
    {
        f32x4 e4[4];
#pragma unroll
        for (int m = 0; m < 4; ++m) e4[m] = (f32x4){0.f, 0.f, 0.f, 0.f};
        const bf16* Bb = BP + (size_t)(16 * w + fr) * 1024 + 8 * fq;
        bf16x8 bfn[4];
#pragma unroll
        for (int q = 0; q < 4; ++q) bfn[q] = *(const bf16x8*)(Bb + 32 * q);
        S5_GLOAD(0); S5_GSTORE(0); WG_BAR();
#pragma unroll 1
        for (int kg = 0; kg < 8; ++kg) {
            bf16x8 bf[4];
#pragma unroll
            for (int q = 0; q < 4; ++q) bf[q] = bfn[q];
            const int kn = kg + 1 < 8 ? kg + 1 : kg;
            S5_GLOAD(kn);
#pragma unroll
            for (int q = 0; q < 4; ++q) bfn[q] = *(const bf16x8*)(Bb + 32 * (4 * kn + q));
#pragma unroll
            for (int q = 0; q < 4; ++q) { bf16x8 af[4]; S5_LDA(af, kg & 1, q);
#pragma unroll
                for (int m = 0; m < 4; ++m) e4[m] = __builtin_amdgcn_mfma_f32_16x16x32_bf16(bf[q], af[m], e4[m], 0, 0, 0); }
            S5_GSTORE((kg + 1) & 1);
            WG_BAR();
        }
#pragma unroll
        for (int m = 0; m < 4; ++m) *(LAS f32x4*)(Ef + (16 * m + fr) * 128 + 16 * w + 4 * fq) = e4[m];
    }
    WG_BAR();
    if (tid < 64) {
        const fl2 a64 = ((const fl2*)(a.ws + WS_A64))[lg * 64 + tid]; float xr = 0.f, xi = 0.f;
        for (int c = 0; c < 64; ++c) { Xs[c * 136 + tid] = f2bf1(xr); Xs[c * 136 + 64 + tid] = f2bf1(xi);
            const float er = Ef[c * 128 + tid], ei = Ef[c * 128 + 64 + tid]; const float nr = a64.x * xr - a64.y * xi + er, ni = a64.x * xi + a64.y * xr + ei; xr = nr; xi = ni; }
    }
    WG_BAR();
    const f32x4 dsk = *(const f32x4*)(a.in[10] + l * 256 + g * 16 + 4 * fq);
    bf16* YS = (bf16*)(a.ws + WS_YS);
    {
        f32x4 acc[4][4];
#pragma unroll
        for (int i = 0; i < 4; ++i)
#pragma unroll
            for (int m = 0; m < 4; ++m) acc[i][m] = (f32x4){0.f, 0.f, 0.f, 0.f};
        const int tb = 32 * hs + w;
        const int nkb = (tb + 24) / 2 + 1;
        const LAS bf16* Kb = KL + fr * 16 + 8 * (fq & 1);
        const int ngr = hs ? 8 : 4;
        S5_GLOAD(0); S5_GSTORE(0); WG_BAR();
#pragma unroll 1
        for (int kg = 0; kg < ngr; ++kg) {
            const int kn = kg + 1 < ngr ? kg + 1 : kg;
            S5_GLOAD(kn);
#pragma unroll
            for (int q = 0; q < 4; ++q) { const int kb = 4 * kg + q;
                if (kb < nkb) { bf16x8 af[4]; S5_LDA(af, kg & 1, q);
#pragma unroll
                    for (int i = 0; i < 4; ++i) { const int t = tb + 8 * i;
                        if (t >= 2 * kb) { const int lag = t - 2 * kb - (fq >> 1); const bf16x8 v = *(const LAS bf16x8*)(Kb + (lag < 0 ? 0 : lag) * 256); const bf16x8 bf = lag < 0 ? (bf16x8){0, 0, 0, 0, 0, 0, 0, 0} : v;
#pragma unroll
                            for (int m = 0; m < 4; ++m) acc[i][m] = __builtin_amdgcn_mfma_f32_16x16x32_bf16(bf, af[m], acc[i][m], 0, 0, 0); } } } }
            S5_GSTORE((kg + 1) & 1);
            WG_BAR();
        }
#pragma unroll 1
        for (int kc = 0; kc < 4; ++kc) {
            bf16x8 af[4];
#pragma unroll
            for (int m = 0; m < 4; ++m) af[m] = *(const LAS bf16x8*)(Xs + (16 * m + fr) * 136 + 32 * kc + 8 * fq);
#pragma unroll
            for (int i = 0; i < 4; ++i) { const int t = tb + 8 * i; const bf16x8 bf = *(const bf16x8*)(CP + (size_t)(16 * t + fr) * 128 + 32 * kc + 8 * fq);
#pragma unroll
                for (int m = 0; m < 4; ++m) acc[i][m] = __builtin_amdgcn_mfma_f32_16x16x32_bf16(bf, af[m], acc[i][m], 0, 0, 0); }
        }
#pragma unroll
        for (int i = 0; i < 4; ++i)
#pragma unroll
            for (int m = 0; m < 4; ++m) { const int t = tb + 8 * i, inst = 16 * m + fr;
                const u32x2 uv = *(const u32x2*)(U + (size_t)inst * 1024 + 16 * t + 4 * fq);
                const float y0 = gelu_tanh(acc[i][m][0] + dsk[0] * bflo(uv.x)), y1 = gelu_tanh(acc[i][m][1] + dsk[1] * bfhi(uv.x)), y2 = gelu_tanh(acc[i][m][2] + dsk[2] * bflo(uv.y)), y3 = gelu_tanh(acc[i][m][3] + dsk[3] * bfhi(uv.y));
                u32x2 wv2; wv2.x = pk2(y0, y1); wv2.y = pk2(y2, y3);
                *(u32x2*)(YS + ((size_t)b * 4096 + inst * 64 + t) * 256 + g * 16 + 4 * fq) = wv2; if (m == 3) EFENCE(); }
    }
#undef S5_LDA
#undef S5_GLOAD
#undef S5_GSTORE
    WG_BAR();
}

__device__ __forceinline__ void sgu_unit(LAS unsigned char* lds, int l, int win, int wv) {
    CArgs& a = *argp();
    const int tid = otid(wv), lane = tid & 63, w = __builtin_amdgcn_readfirstlane(tid >> 6), fr = lane & 15, fq = lane >> 4;
    const int t0 = win * 128;
    const bf16* VG = (const bf16*)(a.ws + WS_VG); const bf16* UG = (const bf16*)(a.ws + WS_UG);
    LAS bf16* vT = (LAS bf16*)lds;
    const f32x4 gv = *(const f32x4*)(a.in[13] + l * 256 + 4 * lane);
    for (int r = 0; r < 16; ++r) { const int j = w * 16 + r;
        const u32x2 v = *(const u32x2*)(VG + (size_t)(t0 + j) * 256 + 4 * lane);
        const float x0 = bflo(v.x), x1 = bfhi(v.x), x2 = bflo(v.y), x3 = bfhi(v.y);
        const float ss = wave_sum((x0 * x0 + x1 * x1) + (x2 * x2 + x3 * x3)); const float rn = rsqrtf(ss * (1.0f / 256.0f) + 1e-6f);
        vT[(4 * lane + 0) * 136 + j] = f2bf1(x0 * rn * gv[0]); vT[(4 * lane + 1) * 136 + j] = f2bf1(x1 * rn * gv[1]); vT[(4 * lane + 2) * 136 + j] = f2bf1(x2 * rn * gv[2]); vT[(4 * lane + 3) * 136 + j] = f2bf1(x3 * rn * gv[3]); }
    WG_BAR();
    const int h = w >> 1, ib0 = 4 * (w & 1);
    const bf16* WS = (const bf16*)(a.ws + WS_WSB) + ((size_t)(l * 4 + h)) * 16384;
    f32x4 acc[4][4];
#pragma unroll
    for (int i = 0; i < 4; ++i)
#pragma unroll
        for (int c = 0; c < 4; ++c) acc[i][c] = (f32x4){0.f, 0.f, 0.f, 0.f};
    const int nks = (w & 1) ? 4 : 2;
    for (int ks = 0; ks < nks; ++ks) {
        bf16x8 wf[4], vf[4];
#pragma unroll
        for (int i = 0; i < 4; ++i) wf[i] = *(const bf16x8*)(WS + (size_t)(16 * (ib0 + i) + fr) * 128 + 32 * ks + 8 * fq);
#pragma unroll
        for (int c = 0; c < 4; ++c) vf[c] = *(const LAS bf16x8*)(vT + (h * 64 + 16 * c + fr) * 136 + 32 * ks + 8 * fq);
#pragma unroll
        for (int i = 0; i < 4; ++i)
#pragma unroll
            for (int c = 0; c < 4; ++c) acc[i][c] = __builtin_amdgcn_mfma_f32_16x16x32_bf16(vf[c], wf[i], acc[i][c], 0, 0, 0);
    }
    bf16* MIX = (bf16*)(a.ws + WS_MIX);
#pragma unroll
    for (int i = 0; i < 4; ++i) { const int ii = 16 * (ib0 + i) + fr; const float bs = a.in[15][(l * 4 + h) * 128 + ii];
#pragma unroll
        for (int c = 0; c < 4; ++c) { const int ch = h * 64 + 16 * c + 4 * fq; const u32x2 uv = *(const u32x2*)(UG + (size_t)(t0 + ii) * 256 + ch);
            u32x2 wv; wv.x = pk2(bflo(uv.x) * (acc[i][c][0] + bs), bfhi(uv.x) * (acc[i][c][1] + bs)); wv.y = pk2(bflo(uv.y) * (acc[i][c][2] + bs), bfhi(uv.y) * (acc[i][c][3] + bs));
            *(u32x2*)(MIX + (size_t)(t0 + ii) * 1024 + 256 + ch) = wv; } }
    WG_BAR();
}

__global__ void __launch_bounds__(512, 2) fwd_mega(Args a_unused) {
    extern __shared__ __attribute__((aligned(16))) unsigned char lds_raw[];
    LAS unsigned char* lds = (LAS unsigned char*)lds_raw;
    cg::grid_group grid = cg::this_grid();
    const int G = gridDim.x, bx = blockIdx.x;
    const int wv = __builtin_amdgcn_readfirstlane((int)threadIdx.x >> 6);
    { const int t0_ = otid(wv); if (t0_ < 2) ((volatile LAS unsigned*)(lds + BARST_OFF))[t0_] = 0u; __syncthreads();
      (void)xcd_barrier_post((unsigned*)(argp()->ws + WS_BAR), (volatile LAS unsigned*)(lds + BARST_OFF), t0_ == 0); }
    int ph = 0;
    const int ph_lo = argp()->ph_lo, ph_hi = argp()->ph_hi;
#define RUN() (ph_lo <= ph && ph < ph_hi)
#define SEAM() do { if (ph_lo <= ph && ph + 1 < ph_hi) { if (argp()->ph_lo == 0x7fffffff) grid.sync();     \
        XcdBarrier xb_; xb_.bar = (unsigned*)(argp()->ws + WS_BAR); xb_.x = xb_xcc_id(); xb_.st = (volatile LAS unsigned*)(lds + BARST_OFF); xcd_barrier(xb_, otid(wv) == 0); } ++ph; } while (0)
    if (RUN() && EN_P) REPS(0) prologue(lds, wv);
    SEAM();
#pragma unroll 1
    for (int l = 0; l < NLAY; ++l) {
        if (RUN() && EN_A) REPS(1) {
            CArgs& a = *argp(); unsigned char* ws = a.ws;
            pg8::Gemm g{(const bf16*)(ws + WS_HB), (const bf16*)(ws + WS_WIN) + (size_t)l * 2304 * 1024, MTOK, INCOLS, 1024}; pg8::InProjOrder S; S.init(bx);
            pg8::EpiInProj E{(const float*)(ws + WS_SSQ), (bf16*)(ws + WS_US), (bf16*)(ws + WS_UG), (bf16*)(ws + WS_VG), (bf16*)(ws + WS_QB), (bf16*)(ws + WS_KB), (bf16*)(ws + WS_VT),
                             a.in[16] + l * 64, a.in[17] + l * 64, (const float*)(ws + WS_ROPE)};
            pg8::gemm_phase<pg8::EpiInProj, pg8::InProjOrder, true, true>(lds, g, S, E, wv);
            if (EN_SGU) { const int sp = S.sgu_panel(); if (sp >= 0) { sgu_unit(lds, l, 2 * sp, wv); sgu_unit(lds, l, 2 * sp + 1, wv); } }
        }
        SEAM();
        if (RUN()) {
            if (EN_S5) REPS(2) { const int xi = bx >> 3, rem = xi & 15; s5_unit(lds, l, rem >> 1, 2 * (bx & 7) + (xi >> 4), rem & 1, wv); }
            if (EN_ATT) REPS(3) {
                CArgs& a = *argp(); unsigned char* ws = a.ws;
                const float lam = ((const float*)(ws + WS_MISC))[l];
                const float omli = 1.0f - (0.8f - 0.6f * __expf(-0.3f * (float)l));
                const float* subg = a.in[22] + l * 128;
#pragma unroll 1
                for (int ui = 0; ui < 4; ++ui) { const int xi = bx >> 3; const int bh = 2 * (bx & 7) + (xi >> 4) + 16 * (ui >> 1), s = xi & 15;
                    attn_unit(lds, (const bf16*)(ws + WS_QB), (const bf16*)(ws + WS_KB), (const bf16*)(ws + WS_VT), (bf16*)(ws + WS_MIX), subg, lam, omli, bh >> 2, bh & 3, (ui & 1) ? s : 31 - s, wv); }
            }
        }
        SEAM();
        if (RUN() && EN_C) {
            CArgs& a = *argp(); unsigned char* ws = a.ws;
            pg8::Gemm g{(const bf16*)(ws + WS_YS), (const bf16*)(ws + WS_WGLU) + (size_t)l * 65536, MTOK, 256, 256}; pg8::StaticOrder S; S.init(MTOK, 256, G, bx);
            pg8::EpiGlu E{(const bf16*)(ws + WS_YS), a.in[12] + l * 256, (bf16*)(ws + WS_MIX)};
            pg8::gemm_phase<pg8::EpiGlu, pg8::StaticOrder, true, true>(lds, g, S, E, wv);
        }
        SEAM();
        if (RUN() && EN_C) {
            CArgs& a = *argp(); unsigned char* ws = a.ws;
            pg8::Gemm g{(const bf16*)(ws + WS_MIX), (const bf16*)(ws + WS_WOUT) + (size_t)l * 1024 * 1024, MTOK, 1024, 1024}; pg8::StaticOrder S; S.init(MTOK, 1024, G, bx);
            pg8::EpiResid E{l == 0 ? a.in[0] : nullptr, nullptr, (bf16*)(ws + WS_HB), (float*)(ws + WS_SSQ) + (size_t)MTOK * 4, (LAS float*)(lds + XL_OFF)};
            pg8::gemm_phase<pg8::EpiResid, pg8::StaticOrder, true, true>(lds, g, S, E, wv);
        }
        SEAM();
        if (RUN() && EN_D) REPS(7) {
            CArgs& a = *argp(); unsigned char* ws = a.ws;
            pg8::Gemm g{(const bf16*)(ws + WS_HB), (const bf16*)(ws + WS_WUP) + (size_t)l * 5632 * 1024, MTOK, UPC, 1024}; pg8::StaticOrder S; S.init(MTOK, UPC, G, bx);
            pg8::EpiUp E{ws, a.in[26] + (size_t)l * 3 * UPC, a.in[27] + (size_t)l * UPC, (LAS f32x4*)(lds + XL_OFF)};
            pg8::gemm_phase<pg8::EpiUp, pg8::StaticOrder, true, true>(lds, g, S, E, wv);
        }
        SEAM();
        if (RUN()) {
            CArgs& a = *argp(); unsigned char* ws = a.ws;
            const float* cw = a.in[26] + (size_t)l * 3 * UPC; const float* cb = a.in[27] + (size_t)l * UPC;
            const float* RT = (const float*)(ws + WS_RTOP); const float* RB = (const float*)(ws + WS_RBOT); bf16* Gb = (bf16*)(ws + WS_G);
            for (int i = bx * 512 + otid(wv); i < 128 * 2 * DFF; i += G * 512) {
                const int col = i % DFF, pr = i / DFF, r = pr & 1, pm = pr >> 1;
                float acc2[2];
#pragma unroll
                for (int h = 0; h < 2; ++h) { const int cc = h * DFF + col;
                    const float t0 = RT[((size_t)pm * 2) * UPC + cc], t1 = RT[((size_t)pm * 2 + 1) * UPC + cc];
                    float b0 = 0.f, b1 = 0.f; if (pm & 15) { b0 = RB[((size_t)(pm - 1) * 2) * UPC + cc]; b1 = RB[((size_t)(pm - 1) * 2 + 1) * UPC + cc]; }
                    const float w0 = cw[cc], w1 = cw[UPC + cc], w2 = cw[2 * UPC + cc];
                    acc2[h] = cb[cc] + (r == 0 ? (w2 * t0 + w1 * b1 + w0 * b0) : (w2 * t1 + w1 * t0 + w0 * b1)); }
                Gb[((size_t)pm * 256 + r) * DFF + col] = f2bf1(gelu_tanh(acc2[0]) * acc2[1]);
            }
        }
        SEAM();
        if (RUN() && EN_E) {
            CArgs& a = *argp(); unsigned char* ws = a.ws;
            pg8::Gemm g{(const bf16*)(ws + WS_G), (const bf16*)(ws + WS_WDN) + (size_t)l * 1024 * 2816, MTOK, 1024, DFF}; pg8::StaticOrder S; S.init(MTOK, 1024, G, bx);
            pg8::EpiResid E{nullptr, l + 1 < NLAY ? nullptr : a.out, (bf16*)(ws + WS_HB), l + 1 < NLAY ? (float*)(ws + WS_SSQ) : nullptr, (LAS float*)(lds + XL_OFF)};
            pg8::gemm_phase<pg8::EpiResid, pg8::StaticOrder, true, true>(lds, g, S, E, wv);
        }
        SEAM();
    }
#undef RUN
#undef SEAM
}

constexpr int N_PHASES = 1 + 7 * NLAY;
#ifndef MK_MULTI
#define MK_MULTI 0
#endif
extern "C" void kernel_launch(void* const* d_in, const int* in_sizes, int n_in, void* d_out, int out_size, void* d_ws, size_t ws_size, hipStream_t stream) {
    static int grid = 0;
    if (grid == 0) {
        if (n_in != 29 || out_size != MTOK * DMOD || ws_size < WS_END) { fprintf(stderr, "kernel_launch: unexpected shapes (n_in %d out %d ws %zu)\n", n_in, out_size, ws_size); grid = -1; return; }
        int dev = 0, cus = 0, per_cu = 0;
        hipGetDevice(&dev); hipDeviceGetAttribute(&cus, hipDeviceAttributeMultiprocessorCount, dev);
        hipFuncSetAttribute((const void*)fwd_mega, hipFuncAttributeMaxDynamicSharedMemorySize, LDS_BYTES);
        hipOccupancyMaxActiveBlocksPerMultiprocessor(&per_cu, (const void*)fwd_mega, 512, LDS_BYTES);
        if (per_cu < 1) per_cu = 1;
        grid = 256;
        if (cus < 256) { fprintf(stderr, "kernel_launch: %d CUs < 256: the cooperative grid cannot be co-resident\n", cus); grid = -1; return; }
        (void)hipGetLastError();
    }
    if (grid < 0) return;
    (void)hipMemsetAsync((char*)d_ws + WS_BAR, 0, 16384, stream);
    Args a{};
    for (int i = 0; i < 29; ++i) a.in[i] = (const float*)d_in[i];
    a.out = (float*)d_out; a.ws = (unsigned char*)d_ws;
#if MK_MULTI
    for (int p = 0; p < N_PHASES; ++p) { a.ph_lo = p; a.ph_hi = p + 1; void* args[] = {&a}; hipLaunchCooperativeKernel((void*)fwd_mega, dim3(grid), dim3(512), args, LDS_BYTES, stream); }
#else
    a.ph_lo = 0; a.ph_hi = N_PHASES;
    void* args[] = {&a};
    hipError_t e = hipLaunchCooperativeKernel((void*)fwd_mega, dim3(grid), dim3(512), args, LDS_BYTES, stream);
    if (e != hipSuccess) fprintf(stderr, "cooperative launch failed: %s (grid %d)\n", hipGetErrorString(e), grid);
#endif
}
```

```cpp
#include <hip/hip_runtime.h>
#include <hip/hip_cooperative_groups.h>
#include <cstdio>
#include <cstdint>
namespace cg = cooperative_groups;
constexpr int MTOK = 32768, SEQL = 4096, DMOD = 1024, NLAY = 4, INCOLS = 2304, DFF = 2816, UPC = 5632;
constexpr size_t MiB = 1u << 20;
constexpr size_t WS_SSQ = 438 * MiB;
constexpr size_t WS_MISC = 1 * MiB;
constexpr size_t WS_BAR = 1 * MiB + 65536;
constexpr size_t WS_ROPE = 2 * MiB;
constexpr size_t WS_WSB = 3 * MiB;
constexpr size_t WS_KTAB = 4 * MiB;
constexpr size_t WS_A64 = 6 * MiB;
constexpr size_t WS_BPOW = 8 * MiB;
constexpr size_t WS_CPOW = 24 * MiB;
constexpr size_t WS_WGLU = 40 * MiB;
constexpr size_t WS_WIN = 41 * MiB;
constexpr size_t WS_WOUT = 60 * MiB;
constexpr size_t WS_WUP = 68 * MiB;
constexpr size_t WS_WDN = 112 * MiB;
constexpr size_t WS_HB = 136 * MiB;
constexpr size_t WS_RTOP = 200 * MiB;
constexpr size_t WS_RBOT = 206 * MiB;
constexpr size_t WS_US = 212 * MiB;
constexpr size_t WS_UG = 228 * MiB;
constexpr size_t WS_VG = 244 * MiB;
constexpr size_t WS_QB = 260 * MiB;
constexpr size_t WS_KB = 292 * MiB;
constexpr size_t WS_VT = 324 * MiB;
constexpr size_t WS_YS = 356 * MiB;
constexpr size_t WS_MIX = 372 * MiB;
constexpr size_t WS_G = 212 * MiB;
constexpr size_t WS_END = 442 * MiB;
constexpr int LDS_BYTES = 147456, XL_OFF = 131072, BARST_OFF = 139264;
namespace pg8 {
#define PG8_LAS __attribute__((address_space(3)))
typedef unsigned short bf16_t;
typedef short bf16x8 __attribute__((ext_vector_type(8)));
typedef float f32x4 __attribute__((ext_vector_type(4)));
typedef unsigned u32x4 __attribute__((ext_vector_type(4)));
constexpr int BM = 256, BK = 64, HALF = 128, HTB = HALF * BK * 2  , STAGE_BYTES = 8 * HTB, NXCD = 8, WGM = 8;

__host__ __device__ __forceinline__ int lds_byte(int r, int c) { const int st = (r >> 4) * 2 + (c >> 5), rr = r & 15, cc = c & 31, ob = rr * 64 + cc * 2; return st * 1024 + (ob ^ (((ob >> 9) & 1) << 5)); }
__host__ __device__ __forceinline__ void stage_rc(int b, int& R, int& C) { const int st = b / 1024, sb = b % 1024, swz = sb ^ (((sb >> 9) & 1) << 5); R = (st >> 1) * 16 + swz / 64; C = (st & 1) * 32 + (swz % 64) / 2; }
__host__ __device__ __forceinline__ int perm32(int rho) { const int n = rho >> 4, i = rho & 15; return 8 * (i >> 2) + 4 * n + (i & 3); }

struct Unit { int pm, pn; };
struct Gemm { const bf16_t* A; const bf16_t* Bt; int M, N, K; };

struct StaticOrder {
    int nM, nN, nwg, G, c;
    __host__ __device__ void init(int M, int N, int G_, int c_) { nM = M / BM; nN = N / BM; nwg = nM * nN; G = G_; c = c_; }
    __host__ __device__ bool next(int i, Unit& u) const {
        const long L = (long)i * G + c; if (L >= nwg) return false;
        int wgid = (int)L; { const int q = nwg / NXCD, r = nwg % NXCD, xcd = wgid % NXCD, off = wgid / NXCD; wgid = (xcd < r ? xcd * (q + 1) : r * (q + 1) + (xcd - r) * q) + off; }
        const int nig = WGM * nN, gid = wgid / nig, fm = gid * WGM, gsz = (nM - fm) < WGM ? (nM - fm) : WGM;
        u.pm = fm + ((wgid % nig) % gsz); u.pn = (wgid % nig) / gsz; return true;
    }
    __device__ __forceinline__ void a_ready(const Unit&) const {}
    __device__ __forceinline__ void done(const Unit&) const {}
};

struct FixedOrder {
    int pm, pn0, n;
    __host__ __device__ bool next(int i, Unit& u) const { if (i >= n) return false; u.pm = pm; u.pn = pn0 + i; return true; }
    __device__ __forceinline__ void a_ready(const Unit&) const {}
    __device__ __forceinline__ void done(const Unit&) const {}
};

struct InProjOrder {
    int base, i, j;
    __host__ __device__ void init(int bx) { const int idx = bx >> 3; base = (bx & 7) * 16; i = idx >> 2; j = idx & 3; }
    __host__ __device__ bool next(int k, Unit& u) const {
        if (k == 0) { u.pm = base + i; u.pn = 1 + 2 * j; return true; }
        if (k == 1) { u.pm = base + i; u.pn = (j == 0) ? 2 : (j == 1) ? 8 : (j == 2) ? 6 : 4; return true; }
        if (k == 2) { u.pm = base + 8 + i; u.pn = (j == 0) ? 3 : (j == 1) ? 1 : 1 + 2 * j; return true; }
        if (k == 3) { u.pm = base + 8 + i; u.pn = (j == 0) ? 8 : (j == 1) ? 2 : (j == 2) ? 6 : 4; return true; }
        if (k == 4 && j >= 2) { u.pm = base + (j == 3 ? 8 : 0) + i; u.pn = 0; return true; }
        return false;
    }
    __host__ __device__ int sgu_panel() const { return j == 0 ? base + i : (j == 1 ? base + 8 + i : -1); }
    __device__ __forceinline__ void a_ready(const Unit&) const {}
    __device__ __forceinline__ void done(const Unit&) const {}
};

__device__ __forceinline__ unsigned cvt_pk_bf16(float lo, float hi) { unsigned r; asm volatile("v_cvt_pk_bf16_f32 %0, %1, %2" : "=v"(r) : "v"(lo), "v"(hi)); return r; }
typedef float f32x2 __attribute__((ext_vector_type(2)));
__device__ __forceinline__ f32x2 gelu_pk(f32x2 v) {
    const f32x2 av = __builtin_elementwise_abs(v), d = av * 0.2316418882f + 1.0f;
    f32x2 t; t.x = __builtin_amdgcn_rcpf(d.x); t.y = __builtin_amdgcn_rcpf(d.y);
    f32x2 q = t * 0.5307027145f + (-0.7265760135f); q = q * t + 0.7107068705f; q = q * t + (-0.142248368f); q = q * t + 0.127414796f; q = q * t;
    const f32x2 s = (v * v) * (-0.72134752044f);
    f32x2 e; e.x = __builtin_amdgcn_exp2f(s.x); e.y = __builtin_amdgcn_exp2f(s.y);
    const f32x2 m = v * (q * e), r = v - m;
    f32x2 o; o.x = v.x < 0.f ? m.x : r.x; o.y = v.y < 0.f ? m.y : r.y; return o;
}

__device__ __forceinline__ int lane_id_op() { int t; asm volatile("v_mbcnt_lo_u32_b32 %0, -1, 0\n\tv_mbcnt_hi_u32_b32 %0, -1, %0" : "=v"(t)); return t; }
__device__ __forceinline__ float xsum16(float s) { return s + __int_as_float(__builtin_amdgcn_ds_swizzle(__float_as_int(s), 0x401F)); }
__device__ __forceinline__ float xsum32(float s) { auto rr = __builtin_amdgcn_permlane32_swap(__float_as_uint(s), __float_as_uint(s), false, false); return __uint_as_float(rr[0]) + __uint_as_float(rr[1]); }
__device__ __forceinline__ float xmax32(float s) { auto rr = __builtin_amdgcn_permlane32_swap(__float_as_uint(s), __float_as_uint(s), false, false); return fmaxf(__uint_as_float(rr[0]), __uint_as_float(rr[1])); }
#define DPPF(v, ctrl) __int_as_float(__builtin_amdgcn_mov_dpp(__float_as_int(v), (ctrl), 0xf, 0xf, true))
__device__ __forceinline__ float wave_sum64(float v) {
    v += DPPF(v, 0xB1); v += DPPF(v, 0x4E); v += DPPF(v, 0x141); v += DPPF(v, 0x140);
    v = xsum16(v); v = xsum32(v); return v;
}
typedef unsigned u32x2 __attribute__((ext_vector_type(2)));
#ifndef UPV
#define UPV 0
#endif
#define EFENCE() do { asm volatile("" ::: "memory"); __builtin_amdgcn_sched_barrier(0); } while (0)
__device__ __forceinline__ float gelu_tanh(float x) {
    const float e = __builtin_amdgcn_exp2f(x * (-2.302208198f + -0.102943243f * x * x));
    return x * __builtin_amdgcn_rcpf(1.0f + e);
}
__device__ __forceinline__ float sigmoidf_(float z) { return __builtin_amdgcn_rcpf(1.0f + __builtin_amdgcn_exp2f(-1.4426950409f * z)); }
__device__ __forceinline__ float bflo(unsigned w) { return __uint_as_float(w << 16); }
__device__ __forceinline__ float bfhi(unsigned w) { return __uint_as_float(w & 0xffff0000u); }
__device__ __forceinline__ unsigned short f2bf1(float f) { return (unsigned short)(cvt_pk_bf16(f, 0.f) & 0xffffu); }

__device__ __forceinline__ float row_ssq4(const float* base, int row) {
    const f32x4 a = *(const f32x4*)((const char*)base + (unsigned)row * 16u);
    return (a[0] + a[1]) + (a[2] + a[3]);
}
__device__ __forceinline__ void row_scales8(float (&rs)[8], const float* ssq, int row0) {
    float t[8];
#pragma unroll
    for (int i = 0; i < 8; ++i) t[i] = row_ssq4(ssq, row0 + (i >> 2) * HALF + (i & 3) * 16);
#pragma unroll
    for (int i = 0; i < 8; ++i) rs[i] = __builtin_amdgcn_rsqf(t[i] * (1.0f / 1024.0f) + 1e-6f);
}
struct EpiInProj {
    static constexpr bool PERM = true, AFTER_DRAIN = false, CONSTK = false;
    const float* ssq; bf16_t *US, *UG, *VG, *QB, *KB, *VT; const float *qg, *kg; const float* rope;
    __device__ __forceinline__ void operator()(const f32x4 (&acc)[2][2][4][2], const Unit& u, int wr, int wc, int fr, int fq) const {
        asm volatile("" : "+v"(fr), "+v"(fq));
        const int pn = u.pn;
        const bool isqk = (pn >= 3 && pn < 7), isk = pn >= 5;
        float rs8[8]; row_scales8(rs8, ssq, u.pm * BM + wr * 64 + fr);
#pragma unroll
        for (int ai = 0; ai < 2; ++ai) {
#pragma unroll
            for (int m = 0; m < 4; ++m) {
                const int row = u.pm * BM + ai * HALF + wr * 64 + m * 16 + fr;
                const float rs = rs8[ai * 4 + m];
                f32x4 x[2][2];
#pragma unroll
                for (int bj = 0; bj < 2; ++bj)
#pragma unroll
                    for (int n = 0; n < 2; ++n) x[bj][n] = acc[ai][bj][m][n] * rs;
                const int b = row >> 12, s = row & 4095;
                if (pn < 3) {
#pragma unroll
                    for (int bj = 0; bj < 2; ++bj) {
                        const int p = bj * 128 + wc * 32 + fq * 8;
                        u32x4 w; w.x = cvt_pk_bf16(x[bj][0][0], x[bj][0][1]); w.y = cvt_pk_bf16(x[bj][0][2], x[bj][0][3]); w.z = cvt_pk_bf16(x[bj][1][0], x[bj][1][1]); w.w = cvt_pk_bf16(x[bj][1][2], x[bj][1][3]);
                        bf16_t* dst = (pn == 0) ? US + ((size_t)(p >> 4) * MTOK + row) * 16 + (p & 15) : ((pn == 1) ? UG : VG) + (size_t)row * 256 + p;
                        *(u32x4*)dst = w;
                    }
                } else if (isqk) {
                    float ss = 0.f;
#pragma unroll
                    for (int bj = 0; bj < 2; ++bj)
#pragma unroll
                        for (int n = 0; n < 2; ++n) { const f32x4 v = x[bj][n]; ss += (v[0] * v[0] + v[1] * v[1]) + (v[2] * v[2] + v[3] * v[3]); }
                    ss = xsum16(ss); ss = xsum32(ss);
                    const float rinv = __builtin_amdgcn_rsqf(ss * (1.0f / 64.0f) + 1e-6f);
                    const float osc = isk ? 1.0f : 0.18033688011112042f;
                    const float* Gq = isk ? kg : qg; f32x4 gn[2][2];
#pragma unroll
                    for (int bj = 0; bj < 2; ++bj)
#pragma unroll
                        for (int n = 0; n < 2; ++n) gn[bj][n] = *(const f32x4*)(Gq + 32 * bj + 8 * fq + 4 * n);
                    const f32x4* rp = (const f32x4*)(rope + ((size_t)s * 32 + 8 * fq) * 2);
                    const int hm = 4 * ((pn - 3) & 1) + wc, head = hm >> 1, c = hm & 1;
                    bf16_t* dst = (isk ? KB : QB) + ((((size_t)(b * 4 + head) * 2 + c) * 4096 + s) * 64) + 8 * fq;
                    float o1[8], o2[8];
#pragma unroll
                    for (int n = 0; n < 2; ++n) {
                        const f32x4 ra = rp[2 * n], rb = rp[2 * n + 1];
                        const float cs[4] = {ra[0], ra[2], rb[0], rb[2]}, sn[4] = {ra[1], ra[3], rb[1], rb[3]};
#pragma unroll
                        for (int e = 0; e < 4; ++e) {
                            const float y1 = x[0][n][e] * rinv * gn[0][n][e], y2 = x[1][n][e] * rinv * gn[1][n][e];
                            o1[4 * n + e] = (y1 * cs[e] - y2 * sn[e]) * osc; o2[4 * n + e] = (y2 * cs[e] + y1 * sn[e]) * osc;
                        }
                    }
                    u32x4 w1, w2;
                    w1.x = cvt_pk_bf16(o1[0], o1[1]); w1.y = cvt_pk_bf16(o1[2], o1[3]); w1.z = cvt_pk_bf16(o1[4], o1[5]); w1.w = cvt_pk_bf16(o1[6], o1[7]);
                    w2.x = cvt_pk_bf16(o2[0], o2[1]); w2.y = cvt_pk_bf16(o2[2], o2[3]); w2.z = cvt_pk_bf16(o2[4], o2[5]); w2.w = cvt_pk_bf16(o2[6], o2[7]);
                    *(u32x4*)dst = w1; *(u32x4*)(dst + 32) = w2;
                } else {
                    const int par = fr & 1, se = s & ~1;
                    const int spe = (se & ~12) | ((se & 4) << 1) | ((se & 8) >> 1);
#pragma unroll
                    for (int bj = 0; bj < 2; ++bj) {
                        const int head = (pn - 7) * 2 + bj;
                        bf16_t* dstb = VT + ((((size_t)(b * 4 + head) * 64 + (spe >> 6)) * 128 + wc * 32 + fq * 8 + par) * 64 + (spe & 63));
#pragma unroll
                        for (int k = 0; k < 4; ++k) {
                            const float a0 = x[bj][k >> 1][2 * (k & 1)], a1 = x[bj][k >> 1][2 * (k & 1) + 1];
                            const float t0 = DPPF(a0, 0xB1), t1 = DPPF(a1, 0xB1);
                            const float lo = par ? t1 : a0, hi = par ? a1 : t0;
                            *(unsigned*)(dstb + (size_t)(2 * k) * 64) = cvt_pk_bf16(lo, hi);
                        }
                    }
                }
                EFENCE();
            }
        }
    }
};

struct EpiResid {
    static constexpr bool PERM = true, AFTER_DRAIN = false, CONSTK = false;
    const float* basef; float* outf; bf16_t* hb; float* ssq_out; PG8_LAS float* xs;
    __device__ __forceinline__ void operator()(const f32x4 (&acc)[2][2][4][2], const Unit& u, int wr, int wc, int fr, int fq) const {
        asm volatile("" : "+v"(fr), "+v"(fq));
        const size_t off0 = (size_t)(u.pm * BM + wr * 64 + fr) * 1024 + u.pn * BM + wc * 32 + 8 * fq;
#pragma unroll
        for (int ai = 0; ai < 2; ++ai) {
            f32x4 bv[4][2][2];
            if (basef) {
#pragma unroll
                for (int m = 0; m < 4; ++m)
#pragma unroll
                    for (int bj = 0; bj < 2; ++bj)
#pragma unroll
                        for (int n = 0; n < 2; ++n) bv[m][bj][n] = *(const f32x4*)(basef + off0 + (size_t)(ai * HALF + m * 16) * 1024 + bj * HALF + n * 4);
            } else {
                u32x4 hv[4][2];
#pragma unroll
                for (int m = 0; m < 4; ++m)
#pragma unroll
                    for (int bj = 0; bj < 2; ++bj) hv[m][bj] = *(const u32x4*)(hb + off0 + (size_t)(ai * HALF + m * 16) * 1024 + bj * HALF);
#pragma unroll
                for (int m = 0; m < 4; ++m)
#pragma unroll
                    for (int bj = 0; bj < 2; ++bj) { const u32x4 h4 = hv[m][bj];
                        bv[m][bj][0] = (f32x4){bflo(h4.x), bfhi(h4.x), bflo(h4.y), bfhi(h4.y)}; bv[m][bj][1] = (f32x4){bflo(h4.z), bfhi(h4.z), bflo(h4.w), bfhi(h4.w)}; }
            }
#pragma unroll
            for (int m = 0; m < 4; ++m) {
                const int row = u.pm * BM + ai * HALF + wr * 64 + m * 16 + fr;
                const size_t off = off0 + (size_t)(ai * HALF + m * 16) * 1024;
                float ss = 0.f;
#pragma unroll
                for (int bj = 0; bj < 2; ++bj) {
                    const f32x4 o0 = bv[m][bj][0] + acc[ai][bj][m][0], o1 = bv[m][bj][1] + acc[ai][bj][m][1];
                    if (outf) { __builtin_nontemporal_store(o0, (f32x4*)(outf + off + bj * HALF)); __builtin_nontemporal_store(o1, (f32x4*)(outf + off + bj * HALF + 4)); }
                    ss += ((o0[0] * o0[0] + o0[1] * o0[1]) + (o0[2] * o0[2] + o0[3] * o0[3])) + ((o1[0] * o1[0] + o1[1] * o1[1]) + (o1[2] * o1[2] + o1[3] * o1[3]));
                    u32x4 w; w.x = cvt_pk_bf16(o0[0], o0[1]); w.y = cvt_pk_bf16(o0[2], o0[3]); w.z = cvt_pk_bf16(o1[0], o1[1]); w.w = cvt_pk_bf16(o1[2], o1[3]);
                    if (!outf) *(u32x4*)(hb + off + bj * HALF) = w;
                }
                if (ssq_out) { ss = xsum16(ss); ss = xsum32(ss); if (fq == 0) xs[(ai * HALF + wr * 64 + m * 16 + fr) * 4 + wc] = ss; }
            }
            EFENCE();
        }
        if (ssq_out) {
            asm volatile("s_waitcnt lgkmcnt(0)" ::: "memory"); __builtin_amdgcn_s_barrier(); asm volatile("" ::: "memory");
            if (wr == 0) { const int t = wc * 64 + fq * 16 + fr; const f32x4 v = *(const PG8_LAS f32x4*)(xs + t * 4);
                ssq_out[(size_t)(u.pm * BM + t) * 4 + u.pn] = (v[0] + v[1]) + (v[2] + v[3]); }
        }
    }
};

struct EpiGlu {
    static constexpr bool PERM = true, AFTER_DRAIN = false, CONSTK = false;
    const bf16_t* YS; const float* bias; bf16_t* MIX;
    __device__ __forceinline__ void operator()(const f32x4 (&acc)[2][2][4][2], const Unit& u, int wr, int wc, int fr, int fq) const {
        asm volatile("" : "+v"(fr), "+v"(fq));
#pragma unroll
        for (int bj = 0; bj < 2; ++bj)
#pragma unroll
            for (int n = 0; n < 2; ++n) {
                const int p = bj * 128 + wc * 32 + fq * 8 + 4 * n;
                const f32x4 b0 = *(const f32x4*)(bias + p);
#pragma unroll
                for (int ai = 0; ai < 2; ++ai)
#pragma unroll
                    for (int m = 0; m < 4; ++m) {
                        const int row = u.pm * BM + ai * HALF + wr * 64 + m * 16 + fr;
                        const u32x2 yv = *(const u32x2*)(YS + (size_t)row * 256 + p);
                        const f32x4 z = acc[ai][bj][m][n] + b0;
                        u32x2 w; w.x = cvt_pk_bf16(bflo(yv.x) * sigmoidf_(z[0]), bfhi(yv.x) * sigmoidf_(z[1])); w.y = cvt_pk_bf16(bflo(yv.y) * sigmoidf_(z[2]), bfhi(yv.y) * sigmoidf_(z[3]));
                        *(u32x2*)(MIX + (size_t)row * 1024 + p) = w;
                        if (m & 1) EFENCE();
                    }
            }
    }
};

struct EpiUp {
    static constexpr bool PERM = true, AFTER_DRAIN = false, CONSTK = true;
    unsigned char* ws; const float* cw; const float* cb; PG8_LAS f32x4* xl;
    __device__ __forceinline__ void operator()(f32x4 (&acc)[2][2][4][2], const Unit& u, int wr, int wc, int fr, int fq) const {
        asm volatile("" : "+v"(fr), "+v"(fq));
        const int wid = wr * 4 + wc;
        const int cgb = u.pn * 128 + wc * 32 + fq * 8;
        const float* ssq = (const float*)(ws + WS_SSQ) + (size_t)MTOK * 4; bf16_t* G = (bf16_t*)(ws + WS_G); float* rawTop = (float*)(ws + WS_RTOP); float* rawBot = (float*)(ws + WS_RBOT);
        float rs8[8]; row_scales8(rs8, ssq, u.pm * BM + wr * 64 + fr);
#pragma unroll
        for (int ai = 0; ai < 2; ++ai)
#pragma unroll
            for (int m = 0; m < 4; ++m) {
                const int row = u.pm * BM + ai * HALF + wr * 64 + m * 16 + fr;
                const float rs = rs8[ai * 4 + m];
#pragma unroll
                for (int bj = 0; bj < 2; ++bj)
#pragma unroll
                    for (int n = 0; n < 2; ++n) acc[ai][bj][m][n] = acc[ai][bj][m][n] * rs;
            }
#if UPV != 3
        if (fr >= 14) {
#pragma unroll
            for (int ai = 0; ai < 2; ++ai)
#pragma unroll
                for (int bj = 0; bj < 2; ++bj)
#pragma unroll
                    for (int n = 0; n < 2; ++n) xl[((((wid * 2 + ai) * 2 + (fr - 14)) * 2 + bj) * 4 + fq) * 2 + n] = acc[ai][bj][3][n];
        }
        if (wr == 0 && fr < 2) {
#pragma unroll
            for (int bj = 0; bj < 2; ++bj)
#pragma unroll
                for (int n = 0; n < 2; ++n) *(f32x4*)(rawTop + ((size_t)u.pm * 2 + fr) * UPC + bj * DFF + cgb + 4 * n) = acc[0][bj][0][n];
        }
        if (wr == 1 && fr >= 14) {
#pragma unroll
            for (int bj = 0; bj < 2; ++bj)
#pragma unroll
                for (int n = 0; n < 2; ++n) *(f32x4*)(rawBot + ((size_t)u.pm * 2 + (fr - 14)) * UPC + bj * DFF + cgb + 4 * n) = acc[1][bj][3][n];
        }
#endif
        asm volatile("s_waitcnt lgkmcnt(0)" ::: "memory"); __builtin_amdgcn_s_barrier(); asm volatile("" ::: "memory");
        const int src = wid ^ 4;
#pragma unroll
        for (int bj = 0; bj < 2; ++bj)
#pragma unroll
            for (int n = 0; n < 2; ++n) {
                const f32x4 wb = *(const f32x4*)(cb + bj * DFF + cgb + 4 * n), w0 = *(const f32x4*)(cw + bj * DFF + cgb + 4 * n), w1 = *(const f32x4*)(cw + UPC + bj * DFF + cgb + 4 * n), w2 = *(const f32x4*)(cw + 2 * UPC + bj * DFF + cgb + 4 * n);
#pragma unroll
                for (int ai = 0; ai < 2; ++ai)
#pragma unroll
                    for (int mm = 0; mm < 4; ++mm) {
                        const int m = 3 - mm;
                        f32x4 pb;
                        if (m > 0) pb = acc[ai][bj][m - 1][n];
                        else if (wr == 1) pb = xl[((((src * 2 + ai) * 2 + (fr & 1)) * 2 + bj) * 4 + fq) * 2 + n];
                        else if (ai == 1) pb = xl[((((src * 2 + 0) * 2 + (fr & 1)) * 2 + bj) * 4 + fq) * 2 + n];
                        else pb = (f32x4){0.f, 0.f, 0.f, 0.f};
                        const f32x4 cur = acc[ai][bj][m][n]; f32x4 cv;
#pragma unroll
                        for (int e = 0; e < 4; ++e) {
                            const int pbi = __float_as_int(pb[e]), ci = __float_as_int(cur[e]);
                            const int r1 = __builtin_amdgcn_mov_dpp(pbi, 0x121, 0xf, 0xf, false);
                            const int r2 = __builtin_amdgcn_mov_dpp(pbi, 0x122, 0xf, 0xf, false);
                            const float p1 = __int_as_float(__builtin_amdgcn_update_dpp(r1, ci, 0x111, 0xf, 0xf, false));
                            const float p2 = __int_as_float(__builtin_amdgcn_update_dpp(r2, ci, 0x112, 0xf, 0xf, false));
                            cv[e] = wb[e] + w2[e] * cur[e] + w1[e] * p1 + w0[e] * p2;
                        }
                        asm volatile("" : "+v"(cv));
                        acc[ai][bj][m][n] = cv;
                    }
            }
#pragma unroll
        for (int ai = 0; ai < 2; ++ai)
#pragma unroll
            for (int m = 0; m < 4; ++m) {
                const int row = u.pm * BM + ai * HALF + wr * 64 + m * 16 + fr;
                const f32x4 g0 = acc[ai][0][m][0], g1 = acc[ai][0][m][1], v0 = acc[ai][1][m][0], v1 = acc[ai][1][m][1];
                u32x4 w; w.x = cvt_pk_bf16(gelu_tanh(g0[0]) * v0[0], gelu_tanh(g0[1]) * v0[1]); w.y = cvt_pk_bf16(gelu_tanh(g0[2]) * v0[2], gelu_tanh(g0[3]) * v0[3]);
                w.z = cvt_pk_bf16(gelu_tanh(g1[0]) * v1[0], gelu_tanh(g1[1]) * v1[1]); w.w = cvt_pk_bf16(gelu_tanh(g1[2]) * v1[2], gelu_tanh(g1[3]) * v1[3]);
                if (!(ai == 0 && m == 0 && wr == 0 && fr < 2)) *(u32x4*)(G + (size_t)row * DFF + cgb) = w;
                EFENCE();
            }
    }
};

template <class Epi, class Sched, bool ALIGN_EPI = false, bool SP2 = false>
__device__ __forceinline__ void gemm_phase(PG8_LAS unsigned char* lds, const Gemm g, const Sched& S, const Epi& E, int wv) {
    int tid_ = wv * 64 + lane_id_op();
    const int tid = tid_, wid = __builtin_amdgcn_readfirstlane(tid >> 6), lane = tid & 63, wr = wid >> 2, wc = wid & 3, fr = lane & 15, fq = lane >> 4;
    int Kop_ = g.K; if constexpr (!Epi::CONSTK) asm volatile("" : "+s"(Kop_));
    const int K = Kop_, nt = K / BK;
    unsigned voffA[2], voffB[2];
#pragma unroll
    for (int i = 0; i < 2; ++i) { int R, C; stage_rc(tid * 16 + i * 8192, R, C); const int Rb = Epi::PERM ? ((R & ~31) + perm32(R & 31)) : R;
        voffA[i] = (unsigned)(R * K + C) * 2u; voffB[i] = (unsigned)(Rb * K + C) * 2u; }
    const size_t kstep = (size_t)(BK * 2);
    const size_t hstep = (size_t)HALF * K * 2;
    const size_t tstep = 2 * hstep;
    const unsigned ldsw = (unsigned)wid * 1024u;
    const int aoff = lds_byte(wr * 64 + fr, fq * 8), boff = lds_byte(wc * 32 + fr, fq * 8);
#define PG8_SA(b, h) (((b) * 2 + (h)) * HTB)
#define PG8_SB(b, h) ((4 + (b) * 2 + (h)) * HTB)
#define PG8_STAGE(bufoff, gbase, voff) do { _Pragma("unroll") for (int _i = 0; _i < 2; ++_i) \
        __builtin_amdgcn_global_load_lds((const unsigned*)((const char*)(gbase) + (voff)[_i]), (PG8_LAS unsigned*)(lds + (bufoff) + ldsw + _i * 8192), 16, 0, 0); } while (0)
#define PG8_LDA(dst, b, h) do { _Pragma("unroll") for (int m = 0; m < 4; ++m) _Pragma("unroll") for (int k = 0; k < 2; ++k) dst[m][k] = *(const PG8_LAS bf16x8*)(lds + PG8_SA(b, h) + aoff + m * 2048 + k * 1024); } while (0)
#define PG8_LDB(dst, b, h) do { _Pragma("unroll") for (int n = 0; n < 2; ++n) _Pragma("unroll") for (int k = 0; k < 2; ++k) dst[n][k] = *(const PG8_LAS bf16x8*)(lds + PG8_SB(b, h) + boff + n * 2048 + k * 1024); } while (0)
#define PG8_MMA(ai, bj, At, Bt) do { __builtin_amdgcn_s_setprio(1); _Pragma("unroll") for (int m = 0; m < 4; ++m) _Pragma("unroll") for (int n = 0; n < 2; ++n) _Pragma("unroll") for (int k = 0; k < 2; ++k) \
        acc[ai][bj][m][n] = __builtin_amdgcn_mfma_f32_16x16x32_bf16(Bt[n][k], At[m][k], acc[ai][bj][m][n], 0, 0, 0); __builtin_amdgcn_s_setprio(0); } while (0)
#define PG8_WAIT_V(n) asm volatile("s_waitcnt vmcnt(" #n ")" ::: "memory")
#define PG8_WAIT_L(n) asm volatile("s_waitcnt lgkmcnt(" #n ")" ::: "memory")
#define PG8_BAR __builtin_amdgcn_s_barrier()
#define PG8_SCHED __builtin_amdgcn_sched_barrier(0)
    Unit cur, nxt; int ui = 0;
    if (!S.next(0, cur)) return;
    f32x4 acc[2][2][4][2];
#pragma unroll
    for (int a = 0; a < 2; ++a)
#pragma unroll
        for (int b = 0; b < 2; ++b)
#pragma unroll
            for (int m = 0; m < 4; ++m)
#pragma unroll
                for (int n = 0; n < 2; ++n) acc[a][b][m][n] = (f32x4){0.f, 0.f, 0.f, 0.f};
    bf16x8 At[4][2], B0[2][2], B1[2][2];
    const char* cA = (const char*)g.A + (size_t)cur.pm * tstep; const char* cB = (const char*)g.Bt + (size_t)cur.pn * tstep;
    S.a_ready(cur);
    if constexpr (SP2) {
        PG8_STAGE(PG8_SB(0, 0), cB, voffB); PG8_STAGE(PG8_SB(0, 1), cB + hstep, voffB); PG8_STAGE(PG8_SA(0, 0), cA, voffA); PG8_STAGE(PG8_SA(0, 1), cA + hstep, voffA);
        if (wr == 1) PG8_BAR;
        PG8_WAIT_V(2); PG8_BAR;
        PG8_STAGE(PG8_SB(1, 0), cB + kstep, voffB); PG8_STAGE(PG8_SA(1, 0), cA + kstep, voffA); PG8_STAGE(PG8_SB(1, 1), cB + hstep + kstep, voffB);
        PG8_WAIT_V(6); PG8_BAR;
    } else {
        PG8_STAGE(PG8_SB(0, 0), cB, voffB); PG8_STAGE(PG8_SA(0, 0), cA, voffA); PG8_STAGE(PG8_SB(0, 1), cB + hstep, voffB); PG8_STAGE(PG8_SA(0, 1), cA + hstep, voffA);
        if (wr == 1) PG8_BAR;
        PG8_WAIT_V(4); PG8_BAR;
        PG8_STAGE(PG8_SB(1, 0), cB + kstep, voffB); PG8_STAGE(PG8_SA(1, 0), cA + kstep, voffA); PG8_STAGE(PG8_SB(1, 1), cB + hstep + kstep, voffB);
        PG8_WAIT_V(6); PG8_BAR;
    }
    for (;;) {
        const bool has_next = S.next(ui + 1, nxt);
        const char* nA = has_next ? (const char*)g.A + (size_t)nxt.pm * tstep : cA; const char* nB = has_next ? (const char*)g.Bt + (size_t)nxt.pn * tstep : cB;
        for (int t = 0; t < nt; t += 2) {
            const bool last = (t == nt - 2);
            const char* a1 = cA + (size_t)(t + 1) * kstep;
            const char* a2 = last ? nA : cA + (size_t)(t + 2) * kstep; const char* b2 = last ? nB : cB + (size_t)(t + 2) * kstep;
            const char* a3 = a2 + kstep; const char* b3 = b2 + kstep;
            if (last && has_next) S.a_ready(nxt);
            if constexpr (SP2) {
            PG8_LDB(B0, 0, 0); PG8_LDB(B1, 0, 1); PG8_SCHED; PG8_LDA(At, 0, 0); PG8_STAGE(PG8_SA(1, 1), a1 + hstep, voffA);
            PG8_WAIT_V(8); PG8_WAIT_L(0); PG8_BAR; PG8_MMA(0, 0, At, B0); PG8_MMA(0, 1, At, B1); PG8_BAR; PG8_SCHED;
            PG8_LDA(At, 0, 1); PG8_STAGE(PG8_SB(0, 0), b2, voffB); PG8_STAGE(PG8_SB(0, 1), b2 + hstep, voffB); PG8_STAGE(PG8_SA(0, 0), a2, voffA);
            PG8_WAIT_V(8); PG8_WAIT_L(0); PG8_BAR; PG8_MMA(1, 0, At, B0); PG8_MMA(1, 1, At, B1); PG8_BAR; PG8_SCHED;
            PG8_LDB(B0, 1, 0); PG8_LDB(B1, 1, 1); PG8_SCHED; PG8_LDA(At, 1, 0); PG8_STAGE(PG8_SA(0, 1), a2 + hstep, voffA);
            PG8_WAIT_V(8); PG8_WAIT_L(0); PG8_BAR; PG8_MMA(0, 0, At, B0); PG8_MMA(0, 1, At, B1); PG8_BAR; PG8_SCHED;
            PG8_LDA(At, 1, 1); PG8_STAGE(PG8_SB(1, 0), b3, voffB); PG8_STAGE(PG8_SB(1, 1), b3 + hstep, voffB); PG8_STAGE(PG8_SA(1, 0), a3, voffA);
            PG8_WAIT_V(8); PG8_WAIT_L(0); PG8_BAR; PG8_MMA(1, 0, At, B0); PG8_MMA(1, 1, At, B1); PG8_BAR; PG8_SCHED;
            } else {
            PG8_LDB(B0, 0, 0); PG8_SCHED; PG8_LDA(At, 0, 0); PG8_STAGE(PG8_SA(1, 1), a1 + hstep, voffA);
            PG8_WAIT_L(8); PG8_BAR; PG8_WAIT_L(0); PG8_MMA(0, 0, At, B0); PG8_BAR; PG8_SCHED;
            PG8_LDB(B1, 0, 1); PG8_STAGE(PG8_SB(0, 0), b2, voffB);
            PG8_BAR; PG8_WAIT_L(0); PG8_MMA(0, 1, At, B1); PG8_BAR;
            PG8_LDA(At, 0, 1); PG8_STAGE(PG8_SA(0, 0), a2, voffA);
            PG8_BAR; PG8_WAIT_L(0); PG8_MMA(1, 0, At, B0); PG8_BAR; PG8_SCHED;
            PG8_STAGE(PG8_SB(0, 1), b2 + hstep, voffB);
            PG8_WAIT_V(6); PG8_BAR; PG8_MMA(1, 1, At, B1); PG8_BAR;
            PG8_LDB(B0, 1, 0); PG8_SCHED; PG8_LDA(At, 1, 0); PG8_STAGE(PG8_SA(0, 1), a2 + hstep, voffA);
            PG8_WAIT_L(8); PG8_BAR; PG8_WAIT_L(0); PG8_MMA(0, 0, At, B0); PG8_BAR; PG8_SCHED;
            PG8_LDB(B1, 1, 1); PG8_STAGE(PG8_SB(1, 0), b3, voffB);
            PG8_BAR; PG8_WAIT_L(0); PG8_MMA(0, 1, At, B1); PG8_BAR;
            PG8_LDA(At, 1, 1); PG8_STAGE(PG8_SA(1, 0), a3, voffA);
            PG8_BAR; PG8_WAIT_L(0); PG8_MMA(1, 0, At, B0); PG8_BAR; PG8_SCHED;
            PG8_STAGE(PG8_SB(1, 1), b3 + hstep, voffB);
            PG8_WAIT_V(6); PG8_BAR; PG8_MMA(1, 1, At, B1); PG8_BAR;
            }
        }
        if constexpr (ALIGN_EPI) { if (wr == 0) PG8_BAR; }
        if constexpr (!Epi::AFTER_DRAIN) { E(acc, cur, wr, wc, fr, fq); S.done(cur); }
        if (!has_next) break;
#pragma unroll
        for (int a = 0; a < 2; ++a)
#pragma unroll
            for (int b = 0; b < 2; ++b)
#pragma unroll
                for (int m = 0; m < 4; ++m)
#pragma unroll
                    for (int n = 0; n < 2; ++n) acc[a][b][m][n] = (f32x4){0.f, 0.f, 0.f, 0.f};
        cur = nxt; cA = nA; cB = nB; ++ui;
        if constexpr (ALIGN_EPI) { if (wr == 1) PG8_BAR; }
    }
    PG8_WAIT_V(0);
    if constexpr (!ALIGN_EPI) { if (wr == 0) PG8_BAR; }
    PG8_BAR;
    if constexpr (Epi::AFTER_DRAIN) { E.fused(acc, cur, wr, wc, fr, fq, lds, wid, lane); S.done(cur); }
#undef PG8_SA
#undef PG8_SB
#undef PG8_STAGE
#undef PG8_LDA
#undef PG8_LDB
#undef PG8_MMA
#undef PG8_WAIT_V
#undef PG8_WAIT_L
#undef PG8_BAR
#undef PG8_SCHED
}
}
#define LAS __attribute__((address_space(3)))
typedef unsigned short bf16;
typedef short bf16x8 __attribute__((ext_vector_type(8)));
typedef short s16x4 __attribute__((ext_vector_type(4)));
typedef float f32x4 __attribute__((ext_vector_type(4)));
typedef float f32x16 __attribute__((ext_vector_type(16)));
typedef unsigned u32x4 __attribute__((ext_vector_type(4)));
typedef unsigned u32x2 __attribute__((ext_vector_type(2)));
typedef float fl2 __attribute__((ext_vector_type(2)));
__device__ __forceinline__ fl2 mk2(float x, float y) { fl2 r; r.x = x; r.y = y; return r; }
using pg8::cvt_pk_bf16; using pg8::gelu_tanh; using pg8::bflo; using pg8::bfhi; using pg8::f2bf1;


#define XB_TMO      128
#define XB_XCNT(j)  (256  + 64 * (j))
#define XB_XSUB(j)  (1280 + 64 * (j))
#define XB_XGEN(j)  (2304 + 64 * (j))
#define XB_TOP      3328
#define XB_TOPGEN   3392
#define XCD_BAR_WORDS 3456
#define XB_SPIN_CAP (1u << 18)

__device__ __forceinline__ unsigned xb_ld(unsigned* p)              { return __hip_atomic_load(p, __ATOMIC_RELAXED, __HIP_MEMORY_SCOPE_AGENT); }
__device__ __forceinline__ unsigned xb_add(unsigned* p, unsigned v) { return __hip_atomic_fetch_add(p, v, __ATOMIC_RELAXED, __HIP_MEMORY_SCOPE_AGENT); }
__device__ __forceinline__ unsigned xb_xcc_id() { return (unsigned)__builtin_amdgcn_s_getreg((3 << 11) | 20) & 0xFu; }
#define XB_SPIN(cond, bar) do { unsigned _sp = 0; while (cond) { __builtin_amdgcn_s_sleep(1); \
    if ((++_sp & 255u) == 0u) { if (xb_ld(&(bar)[XB_TMO])) break; if (_sp > XB_SPIN_CAP) { atomicAdd(&(bar)[XB_TMO], 1u); break; } } } } while (0)

struct XcdBarrier {
    unsigned* bar; unsigned x;
    volatile LAS unsigned* st;
};

__device__ __forceinline__ XcdBarrier xcd_barrier_post(unsigned* bar, volatile LAS unsigned* st, bool leader) {
    XcdBarrier b; b.bar = bar; b.x = xb_xcc_id(); b.st = st;
    if (leader) (void)xb_add(&bar[XB_XCNT(b.x)], 1u);
    return b;
}
__device__ __forceinline__ void xcd_barrier_complete(unsigned* bar, unsigned x, unsigned& nloc, unsigned& nx) {
    const unsigned G = gridDim.x * gridDim.y * gridDim.z;
    unsigned sum, cnt, mine, sp = 0u;
    for (;;) {
        sum = 0u; cnt = 0u; mine = 0u;
#pragma unroll
        for (unsigned j = 0; j < 16; ++j) { const unsigned c = xb_ld(&bar[XB_XCNT(j)]); sum += c; cnt += (c > 0u) ? 1u : 0u; mine = (j == x) ? c : mine; }
        if (sum == G) break;
        __builtin_amdgcn_s_sleep(1);
        if ((++sp & 255u) == 0u) { if (xb_ld(&bar[XB_TMO])) break; if (sp > XB_SPIN_CAP) { atomicAdd(&bar[XB_TMO], 1u); break; } }
    }
    nloc = mine > 0u ? mine : 1u; nx = cnt > 0u ? cnt : 1u;
}

__device__ __forceinline__ void xcd_barrier(const XcdBarrier& b, bool leader) {
    asm volatile("s_waitcnt vmcnt(0)" ::: "memory");
    __syncthreads();
    if (leader) {
        unsigned* bar = b.bar;
        __builtin_amdgcn_s_waitcnt(0);
        unsigned nloc = b.st[0], nx = b.st[1];
        if (nloc == 0u) { xcd_barrier_complete(bar, b.x, nloc, nx); b.st[0] = nloc; b.st[1] = nx; }
        const unsigned old = xb_add(&bar[XB_XSUB(b.x)], 1u);
        const unsigned gen = old / nloc;
        if (old + 1u == (gen + 1u) * nloc) {
            __builtin_amdgcn_fence(__ATOMIC_RELEASE, "agent");
            asm volatile("s_waitcnt vmcnt(0)" ::: "memory");
            const unsigned og = xb_add(&bar[XB_TOP], 1u);
            const unsigned tg = og / nx;
            if (og + 1u == (tg + 1u) * nx) xb_add(&bar[XB_TOPGEN], 1u);
            else XB_SPIN(xb_ld(&bar[XB_TOPGEN]) == tg, bar);
            __builtin_amdgcn_fence(__ATOMIC_ACQUIRE, "agent");
            xb_add(&bar[XB_XGEN(b.x)], 1u);
            asm volatile("s_waitcnt vmcnt(0)" ::: "memory");
        } else {
            XB_SPIN(xb_ld(&bar[XB_XGEN(b.x)]) == gen, bar);
            __builtin_amdgcn_fence(__ATOMIC_ACQUIRE, "agent");
            asm volatile("s_waitcnt vmcnt(0)" ::: "memory");
        }
    }
    __syncthreads();
}

#ifndef EN_MASK
#define EN_MASK 0x1ff
#endif
#ifndef PROBE_CE
#define PROBE_CE 0
#endif
#ifndef REP_MASK
#define REP_MASK 0
#endif
#define REPS(bit) for (int rep_ = 0; rep_ <= ((REP_MASK >> (bit)) & 1); ++rep_)
#define EN_P ((EN_MASK>>0)&1)
#define EN_A ((EN_MASK>>1)&1)
#define EN_S5 ((EN_MASK>>2)&1)
#define EN_ATT ((EN_MASK>>3)&1)
#define EN_SGU ((EN_MASK>>4)&1)
#define EN_G ((EN_MASK>>5)&1)
#define EN_C ((EN_MASK>>6)&1)
#define EN_D ((EN_MASK>>7)&1)
#define EN_E ((EN_MASK>>8)&1)
struct Args { const float* in[29]; float* out; unsigned char* ws; int ph_lo, ph_hi; };
typedef const Args __attribute__((address_space(4))) CArgs;
__device__ __forceinline__ CArgs* argp() { CArgs* p = (CArgs*)__builtin_amdgcn_kernarg_segment_ptr(); asm volatile("" : "+s"(p)); return p; }

__device__ __forceinline__ int otid(int wv) { return wv * 64 + pg8::lane_id_op(); }
__device__ __forceinline__ float wave_sum(float v) { return pg8::wave_sum64(v); }
__device__ __forceinline__ unsigned pk2(float lo, float hi) { return cvt_pk_bf16(lo, hi); }
#define EFENCE() do { asm volatile("" ::: "memory"); __builtin_amdgcn_sched_barrier(0); } while (0)
#define LDS_WAIT() asm volatile("s_waitcnt lgkmcnt(0)" ::: "memory")
#define WG_BAR() do { asm volatile("s_waitcnt vmcnt(0) lgkmcnt(0)" ::: "memory"); __builtin_amdgcn_s_barrier(); asm volatile("" ::: "memory"); } while (0)

__device__ __forceinline__ void sincos_rev(double ang, float& c, float& s) {
    const double rev = ang * 0.15915494309189535; const float f = (float)(rev - __builtin_rint(rev));
    c = __builtin_amdgcn_cosf(f); s = __builtin_amdgcn_sinf(f);
}

__device__ __forceinline__ void tr_item(const float* W, int Nsrc, int k0, int nsrc0, const float* gain, bf16* WT, int K, int ndst0, LAS float* scr, int lane) {
    float wv_[32];
#pragma unroll
    for (int i = 0; i < 32; ++i) wv_[i] = W[(size_t)(k0 + 2 * i + (lane >> 5)) * Nsrc + nsrc0 + (lane & 31)];
#pragma unroll
    for (int i = 0; i < 32; ++i) { const int kk = 2 * i + (lane >> 5); const float g = gain ? gain[k0 + kk] : 1.0f; scr[kk * 33 + (lane & 31)] = wv_[i] * g; }
    LDS_WAIT(); asm volatile("" ::: "memory");
    const int c = lane & 7;
#pragma unroll
    for (int j = 0; j < 4; ++j) { const int n = (lane >> 3) + 8 * j; const LAS float* s = scr + (8 * c) * 33 + n;
        u32x4 o; o.x = pk2(s[0 * 33], s[1 * 33]); o.y = pk2(s[2 * 33], s[3 * 33]); o.z = pk2(s[4 * 33], s[5 * 33]); o.w = pk2(s[6 * 33], s[7 * 33]);
        *(u32x4*)(WT + (size_t)(ndst0 + n) * K + k0 + 8 * c) = o; }
    LDS_WAIT(); asm volatile("" ::: "memory");
}

__device__ __forceinline__ void s5_tables(LAS unsigned char* lds, int l, int g, int part, int wv) {
    CArgs& a = *argp();
    const int tid = otid(wv);
    LAS fl2* apw = (LAS fl2*)lds;
    LAS fl2* bbL = (LAS fl2*)(lds + 65 * 64 * 8);
    LAS fl2* cL = bbL + 64 * 16;
    const int lg = l * 16 + g;
    const float dt = __expf(a.in[5][lg]);
    { const int p = tid & 63; const float are = a.in[3][lg * 64 + p], aim = a.in[4][lg * 64 + p];
      for (int j = tid >> 6; j <= 64; j += 8) { const float mag = __expf(are * dt * (float)j); float c, s; sincos_rev((double)(aim * dt) * (double)j, c, s); apw[j * 64 + p] = mk2(mag * c, mag * s); } }
    for (int i = tid; i < 1024; i += 512) { const int h = i >> 6, p = i & 63; cL[h * 64 + p] = mk2(a.in[8][(size_t)lg * 1024 + h * 64 + p], a.in[9][(size_t)lg * 1024 + h * 64 + p]); }
    WG_BAR();
    for (int i = tid; i < 1024; i += 512) { const int p = i >> 4, h = i & 15;
        const float are = a.in[3][lg * 64 + p], aim = a.in[4][lg * 64 + p]; const fl2 ab = apw[64 + p];
        const float nr = ab.x - 1.0f, ni = ab.y, den = 1.0f / (are * are + aim * aim);
        const float qr = (nr * are + ni * aim) * den, qi = (ni * are - nr * aim) * den;
        const float br = a.in[6][(size_t)lg * 1024 + p * 16 + h], bi = a.in[7][(size_t)lg * 1024 + p * 16 + h];
        bbL[p * 16 + h] = mk2(qr * br - qi * bi, qr * bi + qi * br); }
    if (tid < 64 && part == 0) { const fl2 v = apw[64 * 64 + tid]; ((fl2*)(a.ws + WS_A64))[lg * 64 + tid] = v; }
    WG_BAR();
    bf16* KT = (bf16*)(a.ws + WS_KTAB) + (size_t)lg * 16384;
    for (int idx = tid + part * 4096; idx < (part + 1) * 4096; idx += 512) { const int j = idx >> 8, hp = (idx >> 4) & 15, h = idx & 15; float acc = 0.f;
        for (int p = 0; p < 64; ++p) { const fl2 c = cL[hp * 64 + p], ap = apw[j * 64 + p], b = bbL[p * 16 + h];
            const float tr = c.x * ap.x - c.y * ap.y, ti = c.x * ap.y + c.y * ap.x; acc += tr * b.x - ti * b.y; }
        KT[idx] = f2bf1(acc); }
    bf16* BP = (bf16*)(a.ws + WS_BPOW) + (size_t)lg * 131072;
    for (int idx = tid + part * 32768; idx < (part + 1) * 32768; idx += 512) { const int n = idx >> 10, k = idx & 1023, p = n & 63, t = k >> 4, h = k & 15;
        const fl2 ap = apw[(63 - t) * 64 + p], b = bbL[p * 16 + h];
        BP[idx] = f2bf1(n < 64 ? (ap.x * b.x - ap.y * b.y) : (ap.x * b.y + ap.y * b.x)); }
    bf16* CP = (bf16*)(a.ws + WS_CPOW) + (size_t)lg * 131072;
    for (int idx = tid + part * 32768; idx < (part + 1) * 32768; idx += 512) { const int n = idx >> 7, k = idx & 127, p = k & 63, t = n >> 4, hp = n & 15;
        const fl2 ap = apw[(t + 1) * 64 + p], c = cL[hp * 64 + p];
        CP[idx] = f2bf1(k < 64 ? (c.x * ap.x - c.y * ap.y) : -(c.x * ap.y + c.y * ap.x)); }
    WG_BAR();
}

__device__ __forceinline__ void prologue(LAS unsigned char* lds, int wv) {
    CArgs& a = *argp();
    const int tid = otid(wv), lane = tid & 63, wave = __builtin_amdgcn_readfirstlane(tid >> 6);
    const int G = gridDim.x, bx = blockIdx.x;
    const int gt = bx * 512 + tid, NT = G * 512;
    { fl2* R = (fl2*)(a.ws + WS_ROPE);
      for (int i = gt; i < 4096 * 32; i += NT) { const int s = i >> 5, j = i & 31; const float inv = exp2f(-(float)j * (13.287712379549449f / 32.0f)); const float ang = (float)s * inv; float c, sn; sincos_rev((double)ang, c, sn); R[i] = mk2(c, sn); } }
    { bf16* WSB = (bf16*)(a.ws + WS_WSB);
      for (int i = gt; i < 4 * 4 * 128 * 128; i += NT) { const int ii = (i >> 7) & 127, jj = i & 127; WSB[i] = ((jj >> 6) <= (ii >> 6)) ? f2bf1(a.in[14][i]) : (bf16)0; } }
    if (bx == 0 && wave < 4) { const int l = wave; const float d1 = wave_sum(a.in[18][l * 64 + lane] * a.in[19][l * 64 + lane]), d2 = wave_sum(a.in[20][l * 64 + lane] * a.in[21][l * 64 + lane]);
        if (lane == 0) ((float*)(a.ws + WS_MISC))[l] = __expf(d1) - __expf(d2) + (0.8f - 0.6f * __expf(-0.3f * (float)l)); }
    for (int t = bx; t < 256; t += G) s5_tables(lds, t >> 6, (t >> 2) & 15, t & 3, wv);
    LAS float* scr = (LAS float*)(lds + wave * 16384);
    const int gw = bx * 8 + wave, NGW = G * 8;
    for (int it = gw; it < 4 * 5920; it += NGW) {
        const int l = it / 5920; int r = it % 5920;
        if (r < 1152) { const int kb = r / 72, gi = r % 72, nd = 32 * gi, pn = nd >> 8, p = nd & 255; int src = nd;
            if (pn >= 3 && pn < 7) { const int bj = p >> 7, wc = (p & 127) >> 5, tq = (pn - 3) & 1; src = (pn < 5 ? 768 : 1280) + (4 * tq + wc) * 64 + 32 * bj; }
            tr_item(a.in[2] + (size_t)l * 1024 * 2304, 2304, 64 * kb, src, a.in[1] + l * 1024, (bf16*)(a.ws + WS_WIN) + (size_t)l * 2304 * 1024, 1024, nd, scr, lane); continue; }
        r -= 1152;
        if (r < 512) { const int kb = r / 32, gi = r % 32; tr_item(a.in[23] + (size_t)l * 1024 * 1024, 1024, 64 * kb, 32 * gi, nullptr, (bf16*)(a.ws + WS_WOUT) + (size_t)l * 1024 * 1024, 1024, 32 * gi, scr, lane); continue; }
        r -= 512;
        if (r < 2816) { const int kb = r / 176, gi = r % 176, nd = 32 * gi, pn = nd >> 8, p = nd & 255, bj = p >> 7, jp = p & 127;
            tr_item(a.in[25] + (size_t)l * 1024 * 5632, 5632, 64 * kb, bj * 2816 + 128 * pn + jp, a.in[24] + l * 1024, (bf16*)(a.ws + WS_WUP) + (size_t)l * 5632 * 1024, 1024, nd, scr, lane); continue; }
        r -= 2816;
        if (r < 1408) { const int kb = r / 32, gi = r % 32; tr_item(a.in[28] + (size_t)l * 2816 * 1024, 1024, 64 * kb, 32 * gi, nullptr, (bf16*)(a.ws + WS_WDN) + (size_t)l * 1024 * 2816, 2816, 32 * gi, scr, lane); continue; }
        r -= 1408;
        { const int kb = r / 8, gi = r % 8; tr_item(a.in[11] + (size_t)l * 256 * 256, 256, 64 * kb, 32 * gi, nullptr, (bf16*)(a.ws + WS_WGLU) + (size_t)l * 256 * 256, 256, 32 * gi, scr, lane); }
    }
    { float* ssq0 = (float*)(a.ws + WS_SSQ); bf16* HB = (bf16*)(a.ws + WS_HB);
      for (int m0 = gw * 4; m0 < MTOK; m0 += NGW * 4) { f32x4 v[4][4];
#pragma unroll
          for (int r = 0; r < 4; ++r) { const f32x4* xr = (const f32x4*)(a.in[0] + (size_t)(m0 + r) * 1024) + lane;
#pragma unroll
              for (int j = 0; j < 4; ++j) v[r][j] = xr[64 * j]; }
#pragma unroll
          for (int r = 0; r < 4; ++r) { float s = 0.f;
#pragma unroll
              for (int j = 0; j < 4; ++j) s += (v[r][j][0] * v[r][j][0] + v[r][j][1] * v[r][j][1]) + (v[r][j][2] * v[r][j][2] + v[r][j][3] * v[r][j][3]);
              s = wave_sum(s); if (lane < 4) ssq0[(size_t)(m0 + r) * 4 + lane] = (lane == 0) ? s : 0.f;
              u32x2* o8 = (u32x2*)(HB + (size_t)(m0 + r) * 1024) + lane;
#pragma unroll
              for (int j = 0; j < 4; ++j) { u32x2 w; w.x = pk2(v[r][j][0], v[r][j][1]); w.y = pk2(v[r][j][2], v[r][j][3]); o8[64 * j] = w; } } } }
}

__device__ __forceinline__ void glds16(const void* gsrc, unsigned lds_dst) { unsigned keep;
    asm volatile("s_mov_b32 %0, m0\n\ts_mov_b32 m0, %2\n\ts_nop 0\n\tglobal_load_lds_dwordx4 %1, off\n\ts_mov_b32 m0, %0" : "=&s"(keep) : "v"(gsrc), "s"(lds_dst) : "memory"); }
__device__ __forceinline__ void attn_unit(LAS unsigned char* lds, const bf16* QB, const bf16* KB, const bf16* VT, bf16* MIX, const float* subg, float lam, float omli, int b, int head, int qb, int wv) {
    const int tid = otid(wv), lane = tid & 63, w = __builtin_amdgcn_readfirstlane(tid >> 6), r32 = lane & 31, hi = lane >> 5;
    const int c = w >> 2, qi = w & 3;
    const int NT = 2 * qb + 2, qchunk = 2 * qb + (qi >> 1);
    const size_t bh = (size_t)(b * 4 + head);
    const bf16* Qp = QB + ((bh * 2 + c) * 4096 + qb * 128 + qi * 32 + r32) * 64;
    bf16x8 qr[4];
#pragma unroll
    for (int d0 = 0; d0 < 4; ++d0) qr[d0] = *(const bf16x8*)(Qp + d0 * 16 + hi * 8);
    asm volatile("" : "+v"(qr[0]), "+v"(qr[1]), "+v"(qr[2]), "+v"(qr[3]));
    constexpr int KSLOT = 16384, VBASE = 3 * KSLOT, VSLOT = 16384;
    const unsigned lds0 = (unsigned)(uintptr_t)lds;
    const int drow = 8 * w + (lane >> 3), dsw = (drow ^ (drow >> 3)) & 7, dch = ((lane & 7) ^ dsw) * 8;
    const bf16* ksrc0 = KB + (bh * 2) * 4096 * 64 + (size_t)drow * 64 + dch; const bf16* ksrc1 = ksrc0 + 4096 * 64;
    const bf16* vsrcA = VT + bh * 128 * 4096 + (size_t)drow * 64 + dch; const bf16* vsrcB = vsrcA + (size_t)64 * 64;
#define A_DMA(j, ks, vs) do { const unsigned kd_ = (unsigned)__builtin_amdgcn_readfirstlane(lds0 + (ks) * KSLOT + w * 1024), vd_ = (unsigned)__builtin_amdgcn_readfirstlane(lds0 + VBASE + (vs) * VSLOT + w * 1024); \
        glds16(ksrc0 + (size_t)(j) * 4096, kd_); glds16(ksrc1 + (size_t)(j) * 4096, kd_ + 8192); glds16(vsrcA + (size_t)(j) * 8192, vd_); glds16(vsrcB + (size_t)(j) * 8192, vd_ + 8192); } while (0)
    const int sw16 = ((r32 ^ (r32 >> 3)) & 7) * 16;
    const int kA = c * 8192 + r32 * 128 + ((hi * 16) ^ sw16), kB = c * 8192 + (r32 + 32) * 128 + ((hi * 16) ^ sw16 ^ 64);
    int vA[4];
#pragma unroll
    for (int i = 0; i < 4; ++i) vA[i] = (32 * i + r32) * 128 + ((hi * 16) ^ sw16 ^ ((i & 1) * 64));
    f32x16 o[4];
#pragma unroll
    for (int i = 0; i < 4; ++i) o[i] = f32x16{};
    float m_run = -1e30f, l_run = 0.f;
    bf16x8 pa[4];
#pragma unroll
    for (int i = 0; i < 4; ++i) pa[i] = (bf16x8){0, 0, 0, 0, 0, 0, 0, 0};
#define SB() __builtin_amdgcn_sched_barrier(0)
#define QK_TILE(P0, P1, ks_) do { \
        const LAS unsigned char* kb = lds + (ks_) * KSLOT; \
        bf16x8 kc0 = *(const LAS bf16x8*)(kb + kA), kc1 = *(const LAS bf16x8*)(kb + kB); \
        _Pragma("unroll") for (int d0 = 0; d0 < 4; ++d0) { \
            bf16x8 kn0 = kc0, kn1 = kc1; \
            if (d0 < 3) { kn0 = *(const LAS bf16x8*)(kb + (kA ^ (32 * (d0 + 1)))); kn1 = *(const LAS bf16x8*)(kb + (kB ^ (32 * (d0 + 1)))); } \
            SB(); \
            if (d0 == 0) { P0 = __builtin_amdgcn_mfma_f32_32x32x16_bf16(kc0, qr[0], f32x16{}, 0, 0, 0); P1 = __builtin_amdgcn_mfma_f32_32x32x16_bf16(kc1, qr[0], f32x16{}, 0, 0, 0); } \
            else { P0 = __builtin_amdgcn_mfma_f32_32x32x16_bf16(kc0, qr[d0], P0, 0, 0, 0); P1 = __builtin_amdgcn_mfma_f32_32x32x16_bf16(kc1, qr[d0], P1, 0, 0, 0); } \
            SB(); \
            kc0 = kn0; kc1 = kn1; } } while (0)
#define ROWMAX(MX, P0, P1) do { MX = fmaxf(P0[0], P1[0]); _Pragma("unroll") for (int r = 1; r < 16; ++r) MX = fmaxf(fmaxf(MX, P0[r]), P1[r]); MX = pg8::xmax32(MX); } while (0)
#define PACK4(DST, P, B) do { u32x4 t_; t_.x = pk2(P[B], P[B + 1]); t_.y = pk2(P[B + 2], P[B + 3]); t_.z = pk2(P[B + 4], P[B + 5]); t_.w = pk2(P[B + 6], P[B + 7]); DST = __builtin_bit_cast(bf16x8, t_); } while (0)
#define PV_FRAG(dst, ks_) do { _Pragma("unroll") for (int i_ = 0; i_ < 4; ++i_) dst[i_] = *(const LAS bf16x8*)(vb + (vA[i_] ^ (32 * (ks_)))); } while (0)
#define PV_GROUP(ks_) do { _Pragma("unroll") for (int i_ = 0; i_ < 4; ++i_) o[i_] = __builtin_amdgcn_mfma_f32_32x32x16_bf16(vc[i_], pa[ks_], o[i_], 0, 0, 0); } while (0)
#define WAIT_BAR(N) asm volatile("s_waitcnt vmcnt(" #N ") lgkmcnt(0)\n\ts_barrier" ::: "memory")
    A_DMA(0, 0, 0); A_DMA(1, 1, 1);
    if (NT > 2) { A_DMA(2, 2, 2); WAIT_BAR(8); } else { WAIT_BAR(4); }
    {
        f32x16 p0, p1; QK_TILE(p0, p1, 0);
        float mx; ROWMAX(mx, p0, p1); m_run = mx;
        p0 = p0 - m_run; p1 = p1 - m_run; float ps = 0.f;
#pragma unroll
        for (int r = 0; r < 16; ++r) { p0[r] = __builtin_amdgcn_exp2f(p0[r]); p1[r] = __builtin_amdgcn_exp2f(p1[r]); ps += p0[r] + p1[r]; }
        l_run = ps;
        PACK4(pa[0], p0, 0); PACK4(pa[1], p0, 8); PACK4(pa[2], p1, 0); PACK4(pa[3], p1, 8);
    }
    if (NT > 2) { WAIT_BAR(4); } else { WAIT_BAR(0); }
    int kn = 1, vcur = 0;
#pragma unroll 1
    for (int j = 0; j < NT; ++j) {
        if (j + 3 < NT) { const int k3 = kn == 0 ? 2 : kn - 1, v3 = vcur == 0 ? 3 : vcur - 1; A_DMA(j + 3, k3, v3); }
        const bool doPV = j <= qchunk, doQK = (j + 1 <= qchunk);
        if (doPV) {
            const LAS unsigned char* vb = lds + VBASE + vcur * VSLOT;
            bf16x8 vc[4], vn[4];
            if (doQK) {
                f32x16 p0, p1; QK_TILE(p0, p1, kn);
                PV_FRAG(vc, 0); PV_FRAG(vn, 1); SB();
                PV_GROUP(0);
                float mx; ROWMAX(mx, p0, p1);
                float alpha = 1.0f; bool resc = false;
                if (__any(mx > m_run + 6.0f)) { const float mn = fmaxf(mx, m_run); alpha = __builtin_amdgcn_exp2f(m_run - mn); m_run = mn; resc = true; }
                SB();
#pragma unroll
                for (int i = 0; i < 4; ++i) vc[i] = vn[i];
                PV_FRAG(vn, 2); SB();
                PV_GROUP(1);
                p0 = p0 - m_run;
#pragma unroll
                for (int r = 0; r < 16; ++r) p0[r] = __builtin_amdgcn_exp2f(p0[r]);
                SB();
#pragma unroll
                for (int i = 0; i < 4; ++i) vc[i] = vn[i];
                PV_FRAG(vn, 3); SB();
                PV_GROUP(2);
                p1 = p1 - m_run;
#pragma unroll
                for (int r = 0; r < 16; ++r) p1[r] = __builtin_amdgcn_exp2f(p1[r]);
                SB();
#pragma unroll
                for (int i = 0; i < 4; ++i) vc[i] = vn[i];
                SB();
                PV_GROUP(3);
                float ps = 0.f;
#pragma unroll
                for (int r = 0; r < 16; ++r) ps += p0[r] + p1[r];
                bf16x8 pn[4]; PACK4(pn[0], p0, 0); PACK4(pn[1], p0, 8); PACK4(pn[2], p1, 0); PACK4(pn[3], p1, 8);
                SB();
                if (resc) { l_run *= alpha;
#pragma unroll
                    for (int i = 0; i < 4; ++i) o[i] = o[i] * alpha; }
                l_run += ps;
#pragma unroll
                for (int i = 0; i < 4; ++i) pa[i] = pn[i];
            } else {
                PV_FRAG(vc, 0);
#pragma unroll
                for (int ks = 0; ks < 4; ++ks) { if (ks < 3) PV_FRAG(vn, ks + 1); SB(); PV_GROUP(ks); SB();
#pragma unroll
                    for (int i = 0; i < 4; ++i) vc[i] = vn[i]; }
            }
        }
        kn = kn == 2 ? 0 : kn + 1; vcur = vcur == 3 ? 0 : vcur + 1;
        if (j + 3 < NT) WAIT_BAR(4); else WAIT_BAR(0);
    }
#undef A_DMA
#undef QK_TILE
#undef ROWMAX
#undef PACK4
#undef PV_FRAG
#undef PV_GROUP
#undef WAIT_BAR
#undef SB
    l_run = pg8::xsum32(l_run);
    const float inv = 1.0f / l_run;
    LAS float* xo = (LAS float*)lds + (size_t)(qi * 32 + r32) * 132;
    if (c == 1) {
#pragma unroll
        for (int i = 0; i < 4; ++i)
#pragma unroll
            for (int q4 = 0; q4 < 4; ++q4) { f32x4 v = {o[i][4 * q4] * inv, o[i][4 * q4 + 1] * inv, o[i][4 * q4 + 2] * inv, o[i][4 * q4 + 3] * inv}; *(LAS f32x4*)(xo + 32 * i + 8 * q4 + 4 * hi) = v; }
    }
    WG_BAR();
    if (c == 0) {
        float ss = 0.f;
#pragma unroll
        for (int i = 0; i < 4; ++i)
#pragma unroll
            for (int q4 = 0; q4 < 4; ++q4) { const f32x4 v = *(const LAS f32x4*)(xo + 32 * i + 8 * q4 + 4 * hi);
#pragma unroll
                for (int e = 0; e < 4; ++e) { const float d = o[i][4 * q4 + e] * inv - lam * v[e]; o[i][4 * q4 + e] = d; ss += d * d; } }
        ss = pg8::xsum32(ss);
        const float rn = __builtin_amdgcn_rsqf(ss * (1.0f / 128.0f) + 1e-6f) * omli;
        bf16* dst = MIX + ((size_t)b * 4096 + qb * 128 + qi * 32 + r32) * 1024 + 512 + head * 128;
#pragma unroll
        for (int i = 0; i < 4; ++i)
#pragma unroll
            for (int q4 = 0; q4 < 4; ++q4) { const int dv = 32 * i + 8 * q4 + 4 * hi; const f32x4 g = *(const f32x4*)(subg + dv);
                u32x2 wv2; wv2.x = pk2(o[i][4 * q4] * rn * g[0], o[i][4 * q4 + 1] * rn * g[1]); wv2.y = pk2(o[i][4 * q4 + 2] * rn * g[2], o[i][4 * q4 + 3] * rn * g[3]);
                *(u32x2*)(dst + dv) = wv2; }
    }
    WG_BAR();
}

__device__ __forceinline__ void s5_unit(LAS unsigned char* lds, int l, int b, int g, int hs, int wv) {
    CArgs& a = *argp();
    const int tid = otid(wv), lane = tid & 63, w = __builtin_amdgcn_readfirstlane(tid >> 6), fr = lane & 15, fq = lane >> 4;
    const int lg = l * 16 + g;
    const bf16* U = (const bf16*)(a.ws + WS_US) + ((size_t)g * MTOK + (size_t)b * 4096) * 16;
    const bf16* BP = (const bf16*)(a.ws + WS_BPOW) + (size_t)lg * 131072;
    const bf16* CP = (const bf16*)(a.ws + WS_CPOW) + (size_t)lg * 131072;
    const bf16* KT = (const bf16*)(a.ws + WS_KTAB) + (size_t)lg * 16384;
    LAS float* Ef = (LAS float*)lds;
    LAS bf16* Xs = (LAS bf16*)(lds + 32768);
    LAS bf16* KL = (LAS bf16*)(lds + 65536);
    { const u32x4* src = (const u32x4*)KT; LAS u32x4* dst = (LAS u32x4*)KL;
#pragma unroll
      for (int i = 0; i < 4; ++i) dst[tid + 512 * i] = src[tid + 512 * i]; }
    LAS unsigned char* CH = lds + 98304;
    const int srow0 = tid >> 4, sseg = tid & 15;
    const bf16* Ust = U + (size_t)srow0 * 1024 + sseg * 8;
    LAS unsigned char* CHst = CH + srow0 * 272 + sseg * 16;
    const LAS unsigned char* CHrd = CH + fr * 272 + fq * 16;
    u32x4 sg0, sg1;
#define S5_GLOAD(kg) do { sg0 = *(const u32x4*)(Ust + 128 * (kg)); sg1 = *(const u32x4*)(Ust + 32 * 1024 + 128 * (kg)); } while (0)
#define S5_GSTORE(buf) do { *(LAS u32x4*)(CHst + (buf) * 17408) = sg0; *(LAS u32x4*)(CHst + (buf) * 17408 + 32 * 272) = sg1; } while (0)
#define S5_LDA(dst, buf, q) do { _Pragma("unroll") for (int m_ = 0; m_ < 4; ++m_) dst[m_] = *(const LAS bf16x8*)(CHrd + (buf) * 17408 + m_ * 16 * 272 + (q) * 64); } while (0)
    {
        f32x4 e4[4];
#pragma unroll
        for (int m = 0; m < 4; ++m) e4[m] = (f32x4){0.f, 0.f, 0.f, 0.f};
        const bf16* Bb = BP + (size_t)(16 * w + fr) * 1024 + 8 * fq;
        bf16x8 bfn[4];
#pragma unroll
        for (int q = 0; q < 4; ++q) bfn[q] = *(const bf16x8*)(Bb + 32 * q);
        S5_GLOAD(0); S5_GSTORE(0); WG_BAR();
#pragma unroll 1
        for (int kg = 0; kg < 8; ++kg) {
            bf16x8 bf[4];
#pragma unroll
            for (int q = 0; q < 4; ++q) bf[q] = bfn[q];
            const int kn = kg + 1 < 8 ? kg + 1 : kg;
            S5_GLOAD(kn);
#pragma unroll
            for (int q = 0; q < 4; ++q) bfn[q] = *(const bf16x8*)(Bb + 32 * (4 * kn + q));
#pragma unroll
            for (int q = 0; q < 4; ++q) { bf16x8 af[4]; S5_LDA(af, kg & 1, q);
#pragma unroll
                for (int m = 0; m < 4; ++m) e4[m] = __builtin_amdgcn_mfma_f32_16x16x32_bf16(bf[q], af[m], e4[m], 0, 0, 0); }
            S5_GSTORE((kg + 1) & 1);
            WG_BAR();
        }
#pragma unroll
        for (int m = 0; m < 4; ++m) *(LAS f32x4*)(Ef + (16 * m + fr) * 128 + 16 * w + 4 * fq) = e4[m];
    }
    WG_BAR();
    if (tid < 64) {
        const fl2 a64 = ((const fl2*)(a.ws + WS_A64))[lg * 64 + tid]; float xr = 0.f, xi = 0.f;
        for (int c = 0; c < 64; ++c) { Xs[c * 136 + tid] = f2bf1(xr); Xs[c * 136 + 64 + tid] = f2bf1(xi);
            const float er = Ef[c * 128 + tid], ei = Ef[c * 128 + 64 + tid]; const float nr = a64.x * xr - a64.y * xi + er, ni = a64.x * xi + a64.y * xr + ei; xr = nr; xi = ni; }
    }
    WG_BAR();
    const f32x4 dsk = *(const f32x4*)(a.in[10] + l * 256 + g * 16 + 4 * fq);
    bf16* YS = (bf16*)(a.ws + WS_YS);
    {
        f32x4 acc[4][4];
#pragma unroll
        for (int i = 0; i < 4; ++i)
#pragma unroll
            for (int m = 0; m < 4; ++m) acc[i][m] = (f32x4){0.f, 0.f, 0.f, 0.f};
        const int tb = 32 * hs + w;
        const int nkb = (tb + 24) / 2 + 1;
        const LAS bf16* Kb = KL + fr * 16 + 8 * (fq & 1);
        const int ngr = hs ? 8 : 4;
        S5_GLOAD(0); S5_GSTORE(0); WG_BAR();
#pragma unroll 1
        for (int kg = 0; kg < ngr; ++kg) {
            const int kn = kg + 1 < ngr ? kg + 1 : kg;
            S5_GLOAD(kn);
#pragma unroll
            for (int q = 0; q < 4; ++q) { const int kb = 4 * kg + q;
                if (kb < nkb) { bf16x8 af[4]; S5_LDA(af, kg & 1, q);
#pragma unroll
                    for (int i = 0; i < 4; ++i) { const int t = tb + 8 * i;
                        if (t >= 2 * kb) { const int lag = t - 2 * kb - (fq >> 1); const bf16x8 v = *(const LAS bf16x8*)(Kb + (lag < 0 ? 0 : lag) * 256); const bf16x8 bf = lag < 0 ? (bf16x8){0, 0, 0, 0, 0, 0, 0, 0} : v;
#pragma unroll
                            for (int m = 0; m < 4; ++m) acc[i][m] = __builtin_amdgcn_mfma_f32_16x16x32_bf16(bf, af[m], acc[i][m], 0, 0, 0); } } } }
            S5_GSTORE((kg + 1) & 1);
            WG_BAR();
        }
#pragma unroll 1
        for (int kc = 0; kc < 4; ++kc) {
            bf16x8 af[4];
#pragma unroll
            for (int m = 0; m < 4; ++m) af[m] = *(const LAS bf16x8*)(Xs + (16 * m + fr) * 136 + 32 * kc + 8 * fq);
#pragma unroll
            for (int i = 0; i < 4; ++i) { const int t = tb + 8 * i; const bf16x8 bf = *(const bf16x8*)(CP + (size_t)(16 * t + fr) * 128 + 32 * kc + 8 * fq);
#pragma unroll
                for (int m = 0; m < 4; ++m) acc[i][m] = __builtin_amdgcn_mfma_f32_16x16x32_bf16(bf, af[m], acc[i][m], 0, 0, 0); }
        }
#pragma unroll
        for (int i = 0; i < 4; ++i)
#pragma unroll
            for (int m = 0; m < 4; ++m) { const int t = tb + 8 * i, inst = 16 * m + fr;
                const u32x2 uv = *(const u32x2*)(U + (size_t)inst * 1024 + 16 * t + 4 * fq);
                const float y0 = gelu_tanh(acc[i][m][0] + dsk[0] * bflo(uv.x)), y1 = gelu_tanh(acc[i][m][1] + dsk[1] * bfhi(uv.x)), y2 = gelu_tanh(acc[i][m][2] + dsk[2] * bflo(uv.y)), y3 = gelu_tanh(acc[i][m][3] + dsk[3] * bfhi(uv.y));
                u32x2 wv2; wv2.x = pk2(y0, y1); wv2.y = pk2(y2, y3);
                *(u32x2*)(YS + ((size_t)b * 4096 + inst * 64 + t) * 256 + g * 16 + 4 * fq) = wv2; if (m == 3) EFENCE(); }
    }
#undef S5_LDA
#undef S5_GLOAD
#undef S5_GSTORE
    WG_BAR();
}

__device__ __forceinline__ void sgu_unit(LAS unsigned char* lds, int l, int win, int wv) {
    CArgs& a = *argp();
    const int tid = otid(wv), lane = tid & 63, w = __builtin_amdgcn_readfirstlane(tid >> 6), fr = lane & 15, fq = lane >> 4;
    const int t0 = win * 128;
    const bf16* VG = (const bf16*)(a.ws + WS_VG); const bf16* UG = (const bf16*)(a.ws + WS_UG);
    LAS bf16* vT = (LAS bf16*)lds;
    const f32x4 gv = *(const f32x4*)(a.in[13] + l * 256 + 4 * lane);
    for (int r = 0; r < 16; ++r) { const int j = w * 16 + r;
        const u32x2 v = *(const u32x2*)(VG + (size_t)(t0 + j) * 256 + 4 * lane);
        const float x0 = bflo(v.x), x1 = bfhi(v.x), x2 = bflo(v.y), x3 = bfhi(v.y);
        const float ss = wave_sum((x0 * x0 + x1 * x1) + (x2 * x2 + x3 * x3)); const float rn = __builtin_amdgcn_rsqf(ss * (1.0f / 256.0f) + 1e-6f);
        vT[(4 * lane + 0) * 136 + j] = f2bf1(x0 * rn * gv[0]); vT[(4 * lane + 1) * 136 + j] = f2bf1(x1 * rn * gv[1]); vT[(4 * lane + 2) * 136 + j] = f2bf1(x2 * rn * gv[2]); vT[(4 * lane + 3) * 136 + j] = f2bf1(x3 * rn * gv[3]); }
    WG_BAR();
    const int h = w >> 1, ib0 = 4 * (w & 1);
    const bf16* WS = (const bf16*)(a.ws + WS_WSB) + ((size_t)(l * 4 + h)) * 16384;
    f32x4 acc[4][4];
#pragma unroll
    for (int i = 0; i < 4; ++i)
#pragma unroll
        for (int c = 0; c < 4; ++c) acc[i][c] = (f32x4){0.f, 0.f, 0.f, 0.f};
    const int nks = (w & 1) ? 4 : 2;
    for (int ks = 0; ks < nks; ++ks) {
        bf16x8 wf[4], vf[4];
#pragma unroll
        for (int i = 0; i < 4; ++i) wf[i] = *(const bf16x8*)(WS + (size_t)(16 * (ib0 + i) + fr) * 128 + 32 * ks + 8 * fq);
#pragma unroll
        for (int c = 0; c < 4; ++c) vf[c] = *(const LAS bf16x8*)(vT + (h * 64 + 16 * c + fr) * 136 + 32 * ks + 8 * fq);
#pragma unroll
        for (int i = 0; i < 4; ++i)
#pragma unroll
            for (int c = 0; c < 4; ++c) acc[i][c] = __builtin_amdgcn_mfma_f32_16x16x32_bf16(vf[c], wf[i], acc[i][c], 0, 0, 0);
    }
    bf16* MIX = (bf16*)(a.ws + WS_MIX);
#pragma unroll
    for (int i = 0; i < 4; ++i) { const int ii = 16 * (ib0 + i) + fr; const float bs = a.in[15][(l * 4 + h) * 128 + ii];
#pragma unroll
        for (int c = 0; c < 4; ++c) { const int ch = h * 64 + 16 * c + 4 * fq; const u32x2 uv = *(const u32x2*)(UG + (size_t)(t0 + ii) * 256 + ch);
            u32x2 wv; wv.x = pk2(bflo(uv.x) * (acc[i][c][0] + bs), bfhi(uv.x) * (acc[i][c][1] + bs)); wv.y = pk2(bflo(uv.y) * (acc[i][c][2] + bs), bfhi(uv.y) * (acc[i][c][3] + bs));
            *(u32x2*)(MIX + (size_t)(t0 + ii) * 1024 + 256 + ch) = wv; } }
    WG_BAR();
}

__global__ void __launch_bounds__(512, 2) fwd_mega(Args a_unused) {
    extern __shared__ __attribute__((aligned(16))) unsigned char lds_raw[];
    LAS unsigned char* lds = (LAS unsigned char*)lds_raw;
    cg::grid_group grid = cg::this_grid();
    const int G = gridDim.x, bx = blockIdx.x;
    const int wv = __builtin_amdgcn_readfirstlane((int)threadIdx.x >> 6);
    { const int t0_ = otid(wv); if (t0_ < 2) ((volatile LAS unsigned*)(lds + BARST_OFF))[t0_] = 0u; __syncthreads();
      (void)xcd_barrier_post((unsigned*)(argp()->ws + WS_BAR), (volatile LAS unsigned*)(lds + BARST_OFF), t0_ == 0); }
    int ph = 0;
    const int ph_lo = argp()->ph_lo, ph_hi = argp()->ph_hi;
#define RUN() (ph_lo <= ph && ph < ph_hi)
#define SEAM() do { if (ph_lo <= ph && ph + 1 < ph_hi) { if (argp()->ph_lo == 0x7fffffff) grid.sync();     \
        XcdBarrier xb_; xb_.bar = (unsigned*)(argp()->ws + WS_BAR); xb_.x = xb_xcc_id(); xb_.st = (volatile LAS unsigned*)(lds + BARST_OFF); xcd_barrier(xb_, otid(wv) == 0); } ++ph; } while (0)
    if (RUN() && EN_P) REPS(0) prologue(lds, wv);
    SEAM();
#pragma unroll 1
    for (int l = 0; l < NLAY; ++l) {
        if (RUN() && EN_A) REPS(1) {
            CArgs& a = *argp(); unsigned char* ws = a.ws;
            pg8::Gemm g{(const bf16*)(ws + WS_HB), (const bf16*)(ws + WS_WIN) + (size_t)l * 2304 * 1024, MTOK, INCOLS, 1024}; pg8::InProjOrder S; S.init(bx);
            pg8::EpiInProj E{(const float*)(ws + WS_SSQ), (bf16*)(ws + WS_US), (bf16*)(ws + WS_UG), (bf16*)(ws + WS_VG), (bf16*)(ws + WS_QB), (bf16*)(ws + WS_KB), (bf16*)(ws + WS_VT),
                             a.in[16] + l * 64, a.in[17] + l * 64, (const float*)(ws + WS_ROPE)};
            pg8::gemm_phase<pg8::EpiInProj, pg8::InProjOrder, true, true>(lds, g, S, E, wv);
            if (EN_SGU) { const int sp = S.sgu_panel(); if (sp >= 0) { sgu_unit(lds, l, 2 * sp, wv); sgu_unit(lds, l, 2 * sp + 1, wv); } }
        }
        SEAM();
        if (RUN()) {
            if (EN_S5) REPS(2) { const int xi = bx >> 3, rem = xi & 15; s5_unit(lds, l, rem >> 1, 2 * (bx & 7) + (xi >> 4), rem & 1, wv); }
            if (EN_ATT) REPS(3) {
                CArgs& a = *argp(); unsigned char* ws = a.ws;
                const float lam = ((const float*)(ws + WS_MISC))[l];
                const float omli = 1.0f - (0.8f - 0.6f * __expf(-0.3f * (float)l));
                const float* subg = a.in[22] + l * 128;
#pragma unroll 1
                for (int ui = 0; ui < 4; ++ui) { const int xi = bx >> 3; const int bh = 2 * (bx & 7) + (xi >> 4) + 16 * (ui >> 1), s = xi & 15;
                    attn_unit(lds, (const bf16*)(ws + WS_QB), (const bf16*)(ws + WS_KB), (const bf16*)(ws + WS_VT), (bf16*)(ws + WS_MIX), subg, lam, omli, bh >> 2, bh & 3, (ui & 1) ? s : 31 - s, wv); }
            }
        }
        SEAM();
        if (RUN() && EN_C) {
            CArgs& a = *argp(); unsigned char* ws = a.ws;
            pg8::Gemm g{(const bf16*)(ws + WS_YS), (const bf16*)(ws + WS_WGLU) + (size_t)l * 65536, MTOK, 256, 256}; pg8::StaticOrder S; S.init(MTOK, 256, G, bx);
            pg8::EpiGlu E{(const bf16*)(ws + WS_YS), a.in[12] + l * 256, (bf16*)(ws + WS_MIX)};
            pg8::gemm_phase<pg8::EpiGlu, pg8::StaticOrder, true, true>(lds, g, S, E, wv);
        }
        SEAM();
        if (RUN() && EN_C) {
            CArgs& a = *argp(); unsigned char* ws = a.ws;
            pg8::Gemm g{(const bf16*)(ws + WS_MIX), (const bf16*)(ws + WS_WOUT) + (size_t)l * 1024 * 1024, MTOK, 1024, 1024}; pg8::StaticOrder S; S.init(MTOK, 1024, G, bx);
            pg8::EpiResid E{l == 0 ? a.in[0] : nullptr, nullptr, (bf16*)(ws + WS_HB), (float*)(ws + WS_SSQ) + (size_t)MTOK * 4, (LAS float*)(lds + XL_OFF)};
            pg8::gemm_phase<pg8::EpiResid, pg8::StaticOrder, true, true>(lds, g, S, E, wv);
        }
        SEAM();
        if (RUN() && EN_D) REPS(7) {
            CArgs& a = *argp(); unsigned char* ws = a.ws;
            pg8::Gemm g{(const bf16*)(ws + WS_HB), (const bf16*)(ws + WS_WUP) + (size_t)l * 5632 * 1024, MTOK, UPC, 1024}; pg8::StaticOrder S; S.init(MTOK, UPC, G, bx);
            pg8::EpiUp E{ws, a.in[26] + (size_t)l * 3 * UPC, a.in[27] + (size_t)l * UPC, (LAS f32x4*)(lds + XL_OFF)};
            pg8::gemm_phase<pg8::EpiUp, pg8::StaticOrder, true, true>(lds, g, S, E, wv);
        }
        SEAM();
        if (RUN()) {
            CArgs& a = *argp(); unsigned char* ws = a.ws;
            const float* cw = a.in[26] + (size_t)l * 3 * UPC; const float* cb = a.in[27] + (size_t)l * UPC;
            const float* RT = (const float*)(ws + WS_RTOP); const float* RB = (const float*)(ws + WS_RBOT); bf16* Gb = (bf16*)(ws + WS_G);
            for (int i = bx * 512 + otid(wv); i < 128 * 2 * DFF; i += G * 512) {
                const int col = i % DFF, pr = i / DFF, r = pr & 1, pm = pr >> 1;
                float acc2[2];
#pragma unroll
                for (int h = 0; h < 2; ++h) { const int cc = h * DFF + col;
                    const float t0 = RT[((size_t)pm * 2) * UPC + cc], t1 = RT[((size_t)pm * 2 + 1) * UPC + cc];
                    float b0 = 0.f, b1 = 0.f; if (pm & 15) { b0 = RB[((size_t)(pm - 1) * 2) * UPC + cc]; b1 = RB[((size_t)(pm - 1) * 2 + 1) * UPC + cc]; }
                    const float w0 = cw[cc], w1 = cw[UPC + cc], w2 = cw[2 * UPC + cc];
                    acc2[h] = cb[cc] + (r == 0 ? (w2 * t0 + w1 * b1 + w0 * b0) : (w2 * t1 + w1 * t0 + w0 * b1)); }
                Gb[((size_t)pm * 256 + r) * DFF + col] = f2bf1(gelu_tanh(acc2[0]) * acc2[1]);
            }
        }
        SEAM();
        if (RUN() && EN_E) {
            CArgs& a = *argp(); unsigned char* ws = a.ws;
            pg8::Gemm g{(const bf16*)(ws + WS_G), (const bf16*)(ws + WS_WDN) + (size_t)l * 1024 * 2816, MTOK, 1024, DFF}; pg8::StaticOrder S; S.init(MTOK, 1024, G, bx);
            pg8::EpiResid E{nullptr, l + 1 < NLAY ? nullptr : a.out, (bf16*)(ws + WS_HB), l + 1 < NLAY ? (float*)(ws + WS_SSQ) : nullptr, (LAS float*)(lds + XL_OFF)};
            pg8::gemm_phase<pg8::EpiResid, pg8::StaticOrder, true, true>(lds, g, S, E, wv);
        }
        SEAM();
    }
#undef RUN
#undef SEAM
}

constexpr int N_PHASES = 1 + 7 * NLAY;
#ifndef MK_MULTI
#define MK_MULTI 0
#endif
extern "C" void kernel_launch(void* const* d_in, const int* in_sizes, int n_in, void* d_out, int out_size, void* d_ws, size_t ws_size, hipStream_t stream) {
    static int grid = 0;
    if (grid == 0) {
        if (n_in != 29 || out_size != MTOK * DMOD || ws_size < WS_END) { fprintf(stderr, "kernel_launch: unexpected shapes (n_in %d out %d ws %zu)\n", n_in, out_size, ws_size); grid = -1; return; }
        int dev = 0, cus = 0, per_cu = 0;
        hipGetDevice(&dev); hipDeviceGetAttribute(&cus, hipDeviceAttributeMultiprocessorCount, dev);
        hipFuncSetAttribute((const void*)fwd_mega, hipFuncAttributeMaxDynamicSharedMemorySize, LDS_BYTES);
        hipOccupancyMaxActiveBlocksPerMultiprocessor(&per_cu, (const void*)fwd_mega, 512, LDS_BYTES);
        if (per_cu < 1) per_cu = 1;
        grid = 256;
        if (cus < 256) { fprintf(stderr, "kernel_launch: %d CUs < 256: the cooperative grid cannot be co-resident\n", cus); grid = -1; return; }
        (void)hipGetLastError();
    }
    if (grid < 0) return;
    (void)hipMemsetAsync((char*)d_ws + WS_BAR, 0, 16384, stream);
    Args a{};
    for (int i = 0; i < 29; ++i) a.in[i] = (const float*)d_in[i];
    a.out = (float*)d_out; a.ws = (unsigned char*)d_ws;
#if MK_MULTI
    for (int p = 0; p < N_PHASES; ++p) { a.ph_lo = p; a.ph_hi = p + 1; void* args[] = {&a}; hipLaunchCooperativeKernel((void*)fwd_mega, dim3(grid), dim3(512), args, LDS_BYTES, stream); }
#else
    a.ph_lo = 0; a.ph_hi = N_PHASES;
    void* args[] = {&a};
    hipError_t e = hipLaunchCooperativeKernel((void*)fwd_mega, dim3(grid), dim3(512), args, LDS_BYTES, stream);
    if (e != hipSuccess) fprintf(stderr, "cooperative launch failed: %s (grid %d)\n", hipGetErrorString(e), grid);
#endif
}
```
